# Optimizing an MI355X kernel written in HIP

```python
import jax, jax.numpy as jnp
from jax import lax
import numpy as np

D_MODEL = 1024
BATCH = 8
SEQ = 4096
DEPTH = 4

CTX_LEN = 256
GRID_W = 64
N_MIXERS = 2
EXPAND = 2
D_INNER = EXPAND * D_MODEL
MLSTM_HEADS = 4
MLSTM_HEAD_DIM = D_INNER // MLSTM_HEADS
CHUNK = 64
CONV_K = 3
FOURIER_GROUPS = 8
FOURIER_GROUP_DIM = D_INNER // FOURIER_GROUPS
N_MLSTM_LAYERS = (DEPTH + 1) // 2
N_FOURIER_LAYERS = DEPTH // 2
LAST_MLSTM = ((DEPTH - 1) // N_MIXERS) * N_MIXERS
EPS = 1e-6

kernel_name = "mlstm_fourier_hybrid_dit_prefix"

H = MLSTM_HEADS
DH = MLSTM_HEAD_DIM


def rmsnorm(x, g):
    xf = x.astype(jnp.float32)
    y = xf * lax.rsqrt(jnp.mean(xf * xf, axis=-1, keepdims=True) + EPS)
    return (y * g.astype(jnp.float32)).astype(x.dtype)


def mlstm_chunk_scan(q, k, v, li, lf, state, emit):
    b, h, n, d = q.shape
    nc = n // CHUNK

    def to_chunks(a):
        a = a.reshape(b, h, nc, CHUNK, *a.shape[3:])
        return jnp.moveaxis(a, 2, 0)

    lower = jnp.tril(jnp.ones((CHUNK, CHUNK), dtype=bool))

    def step(carry, inp):
        C, nv, m = carry
        qc, kc, vc, lic, lfc = inp
        bcum = jnp.cumsum(lfc, axis=-1)
        logw = bcum[..., :, None] - bcum[..., None, :] + lic[..., None, :]
        logw = jnp.where(lower, logw, -jnp.inf)
        log_prev = bcum + m[..., None]
        m_new = jnp.maximum(log_prev, jnp.max(logw, axis=-1))
        w_intra = jnp.exp(logw - m_new[..., None])
        w_prev = jnp.exp(log_prev - m_new)
        out = None
        if emit:
            scores = jnp.einsum('bhjd,bhsd->bhjs', qc, kc) * w_intra
            num = jnp.einsum('bhjs,bhsd->bhjd', scores, vc) + \
                w_prev[..., None] * jnp.einsum('bhvk,bhjk->bhjv', C, qc)
            den = jnp.sum(scores, axis=-1) + w_prev * jnp.einsum('bhk,bhjk->bhj', nv, qc)
            out = num / jnp.maximum(jnp.abs(den), jnp.exp(-m_new))[..., None]
        m_end = m_new[..., -1]
        w_src = jnp.exp(bcum[..., -1:] - bcum + lic - m_end[..., None])
        decay = jnp.exp(bcum[..., -1] + m - m_end)
        C_new = decay[..., None, None] * C + jnp.einsum('bhsv,bhsk->bhvk', w_src[..., None] * vc, kc)
        n_new = decay[..., None] * nv + jnp.einsum('bhs,bhsk->bhk', w_src, kc)
        return (C_new, n_new, m_end), out

    state, hs = lax.scan(step, state, tuple(to_chunks(a) for a in (q, k, v, li, lf)))
    if emit:
        hs = jnp.moveaxis(hs, 0, 2).reshape(b, h, n, d)
    return hs, state


def mlstm_inputs(hmod, grid_rows, grid_cols, w_in, conv_w, conv_b, w_q, w_k, w_if, b_i, b_f):
    b, n, _ = hmod.shape
    xm, o_pre, z = jnp.split(hmod @ w_in, 3, axis=-1)
    xg = xm.reshape(b, grid_rows, grid_cols, D_INNER)
    xconv = lax.conv_general_dilated(xg, conv_w, (1, 1), 'SAME',
                                     dimension_numbers=('NHWC', 'HWIO', 'NHWC'),
                                     feature_group_count=D_INNER)
    xconv = jax.nn.silu(xconv.reshape(b, n, D_INNER) + conv_b)
    xh = xconv.reshape(b, n, H, DH)
    q = jnp.einsum('bnhd,hde->bhne', xh, w_q).astype(jnp.float32)
    k = (jnp.einsum('bnhd,hde->bhne', xh, w_k) * (DH ** -0.5)).astype(jnp.float32)
    v = xm.reshape(b, n, H, DH).transpose(0, 2, 1, 3).astype(jnp.float32)
    wq_g = w_if[:, 0].reshape(2, H, DH, 2 * H).astype(jnp.float32)
    wk_g = w_if[:, 1].reshape(2, H, DH, 2 * H).astype(jnp.float32)
    wv_g = w_if[:, 2].reshape(2, H, DH, 2 * H).astype(jnp.float32)
    gates = (jnp.einsum('bhne,rheg->rbng', q, wq_g) + jnp.einsum('bhne,rheg->rbng', k, wk_g)
             + jnp.einsum('bhne,rheg->rbng', v, wv_g))
    li = gates[..., :H] + b_i.astype(jnp.float32)[:, None, None, :]
    lf = jax.nn.log_sigmoid(gates[..., H:] + b_f.astype(jnp.float32)[:, None, None, :])
    li = jnp.moveaxis(li, -1, 2)
    lf = jnp.moveaxis(lf, -1, 2)
    return (q, k, v, li, lf), o_pre, z, xconv


def mlstm_output(hsum, o_pre, z, xconv, ln_w, skip, w_out, dtype):
    b, _, n, _ = hsum.shape
    hh = hsum.transpose(0, 2, 1, 3)
    mu = jnp.mean(hh, axis=-1, keepdims=True)
    var = jnp.mean(jnp.square(hh - mu), axis=-1, keepdims=True)
    hn = ((hh - mu) * lax.rsqrt(var + EPS)).reshape(b, n, D_INNER) * ln_w.astype(jnp.float32)
    hn = jax.nn.sigmoid(o_pre.astype(jnp.float32)) * hn
    y = (hn.astype(dtype) + skip * xconv) * jax.nn.silu(z)
    return y @ w_out


def mlstm_branch(h_lat, h_ctx, rows, emit_ctx, w_in, conv_w, conv_b, w_q, w_k, w_if,
                 b_i, b_f, ln_w, skip, w_out):
    lat, o_l, z_l, xc_l = mlstm_inputs(h_lat, rows, GRID_W, w_in, conv_w, conv_b, w_q, w_k, w_if, b_i, b_f)
    ctx, o_c, z_c, xc_c = mlstm_inputs(h_ctx, 1, h_ctx.shape[1], w_in, conv_w, conv_b, w_q, w_k, w_if, b_i, b_f)
    b = h_lat.shape[0]
    zero = (jnp.zeros((b, H, DH, DH), jnp.float32), jnp.zeros((b, H, DH), jnp.float32),
            jnp.zeros((b, H), jnp.float32))
    h_lat_sum = 0.0
    h_ctx_sum = 0.0
    for r, rev in ((0, False), (1, True)):
        fl = (lambda a: jnp.flip(a, 2)) if rev else (lambda a: a)
        qc, kc, vc, lic, lfc = ctx
        ql, kl, vl, lil, lfl = lat
        hc, st = mlstm_chunk_scan(fl(qc), fl(kc), fl(vc), fl(lic[r]), fl(lfc[r]), zero, emit_ctx)
        hl, _ = mlstm_chunk_scan(fl(ql), fl(kl), fl(vl), fl(lil[r]), fl(lfl[r]), st, True)
        h_lat_sum = h_lat_sum + fl(hl)
        if emit_ctx:
            h_ctx_sum = h_ctx_sum + fl(hc)
    y_lat = mlstm_output(h_lat_sum, o_l, z_l, xc_l, ln_w, skip, w_out, h_lat.dtype)
    y_ctx = mlstm_output(h_ctx_sum, o_c, z_c, xc_c, ln_w, skip, w_out, h_ctx.dtype) if emit_ctx else None
    return y_lat, y_ctx


def fourier_branch(hmod, w_in, w_out):
    b, n, _ = hmod.shape
    u, z = jnp.split(hmod @ w_in, 2, axis=-1)
    ug = u.astype(jnp.float32).reshape(b, n, FOURIER_GROUPS, FOURIER_GROUP_DIM)
    f = jnp.fft.fft2(ug, axes=(1, 3), norm='ortho').real
    y = f.reshape(b, n, D_INNER).astype(hmod.dtype) * jax.nn.silu(z)
    return y @ w_out


def setup_inputs(seed: int = 0) -> dict:
    key = jax.random.key(seed)
    ks = jax.random.split(key, 24)
    nA, nB, E = N_MLSTM_LAYERS, N_FOURIER_LAYERS, D_INNER
    nrm = jax.random.normal
    return {
        "x": nrm(ks[0], (BATCH, SEQ, D_MODEL), jnp.float32),
        "c": nrm(ks[1], (BATCH, D_MODEL), jnp.float32),
        "ctx": nrm(ks[2], (BATCH, CTX_LEN, D_MODEL), jnp.float32),
        "c_ctx": nrm(ks[3], (D_MODEL,), jnp.float32),
        "norm_g": 1.0 + 0.1 * nrm(ks[4], (DEPTH, D_MODEL), jnp.float32),
        "w_ada": nrm(ks[5], (DEPTH, D_MODEL, 3 * D_MODEL), jnp.float32) * D_MODEL ** -0.5,
        "b_ada": 0.02 * nrm(ks[6], (DEPTH, 3 * D_MODEL), jnp.float32),
        "m_w_in": nrm(ks[7], (nA, D_MODEL, 3 * E), jnp.float32) * D_MODEL ** -0.5,
        "m_conv_w": nrm(ks[8], (nA, CONV_K, CONV_K, 1, E), jnp.float32) / CONV_K,
        "m_conv_b": 0.02 * nrm(ks[9], (nA, E), jnp.float32),
        "m_w_q": nrm(ks[10], (nA, H, DH, DH), jnp.float32) * DH ** -0.5,
        "m_w_k": nrm(ks[11], (nA, H, DH, DH), jnp.float32) * DH ** -0.5,
        "m_w_if": nrm(ks[12], (nA, 2, 3, E, 2 * H), jnp.float32) * (3 * E) ** -0.5,
        "m_b_i": 0.1 * nrm(ks[13], (nA, 2, H), jnp.float32),
        "m_b_f": jnp.linspace(3.0, 6.0, H, dtype=jnp.float32) + 0.1 * nrm(ks[14], (nA, 2, H), jnp.float32),
        "m_ln_w": 1.0 + 0.1 * nrm(ks[15], (nA, E), jnp.float32),
        "m_skip": 1.0 + 0.1 * nrm(ks[16], (nA, E), jnp.float32),
        "m_w_out": nrm(ks[17], (nA, E, D_MODEL), jnp.float32) * E ** -0.5,
        "f_w_in": nrm(ks[18], (nB, D_MODEL, 2 * E), jnp.float32) * D_MODEL ** -0.5,
        "f_w_out": nrm(ks[19], (nB, E, D_MODEL), jnp.float32) * E ** -0.5,
        "norm_f": 1.0 + 0.1 * nrm(ks[20], (D_MODEL,), jnp.float32),
    }


def reference(x, c, ctx, c_ctx, norm_g, w_ada, b_ada, m_w_in, m_conv_w, m_conv_b, m_w_q, m_w_k,
              m_w_if, m_b_i, m_b_f, m_ln_w, m_skip, m_w_out, f_w_in, f_w_out, norm_f):
    rows = x.shape[1] // GRID_W
    xc = ctx
    sc_lat = jax.nn.silu(c)
    sc_ctx = jax.nn.silu(c_ctx)
    for i in range(DEPTH):
        j = i // N_MIXERS
        update_ctx = i < LAST_MLSTM
        sh, sc, g = jnp.split(sc_lat @ w_ada[i] + b_ada[i], 3, axis=-1)
        h = rmsnorm(x, norm_g[i]) * (1.0 + sc[:, None, :]) + sh[:, None, :]
        need_ctx_in = update_ctx or (i % N_MIXERS == 0)
        if need_ctx_in:
            shc, scc, gc = jnp.split(sc_ctx @ w_ada[i] + b_ada[i], 3, axis=-1)
            hc = rmsnorm(xc, norm_g[i]) * (1.0 + scc) + shc
        if i % N_MIXERS == 0:
            y, yc = mlstm_branch(h, hc, rows, update_ctx, m_w_in[j], m_conv_w[j], m_conv_b[j],
                                 m_w_q[j], m_w_k[j], m_w_if[j], m_b_i[j], m_b_f[j],
                                 m_ln_w[j], m_skip[j], m_w_out[j])
        else:
            y = fourier_branch(h, f_w_in[j], f_w_out[j])
            yc = fourier_branch(hc, f_w_in[j], f_w_out[j]) if update_ctx else None
        x = x + g[:, None, :] * y
        if update_ctx:
            xc = xc + gc * yc
    return rmsnorm(x, norm_f)
```

```cpp
#include <hip/hip_runtime.h>
#include <stdint.h>
#include <stdio.h>

#define LAS __attribute__((address_space(3)))
typedef unsigned short bf16_t;
typedef short bf16x8 __attribute__((ext_vector_type(8)));
typedef float f32x4 __attribute__((ext_vector_type(4)));
typedef unsigned u32x4 __attribute__((ext_vector_type(4)));
typedef unsigned u32x2 __attribute__((ext_vector_type(2)));
typedef short s16x4 __attribute__((ext_vector_type(4)));

constexpr int D = 1024, E = 2048, SEQ = 4096, CTX = 256, NBATCH = 8, NH = 4, DH = 512;
constexpr int HB = 4;
constexpr int TLAT = HB * SEQ;
constexpr int TCTX = HB * CTX;
constexpr int TH = TLAT + TCTX;
constexpr int NTHREADS = 512;
constexpr float EPS = 1e-6f;

constexpr size_t al256(size_t x) { return (x + 255) & ~(size_t)255; }
constexpr size_t WS_BAR = 0;
constexpr size_t WS_MODS = 16384;
constexpr size_t WS_XC = al256(WS_MODS + (size_t)4 * 9 * 3072 * 4);
constexpr size_t WS_LI = al256(WS_XC + (size_t)NBATCH * CTX * D * 4);
constexpr size_t WS_LF = al256(WS_LI + (size_t)2 * TH * 4 * 4);
constexpr size_t WS_FC = al256(WS_LF + (size_t)2 * TH * 4 * 4);
constexpr size_t WS_TCTX = al256(WS_FC + (size_t)256 * 512 * 4);
constexpr size_t WS_WG = al256(WS_TCTX + (size_t)256 * 512 * 2);
constexpr size_t WS_W1 = al256(WS_WG + (size_t)6144 * 128 * 4);
constexpr size_t WS_W2 = al256(WS_W1 + (size_t)6144 * 1024 * 2);
constexpr size_t WS_W3 = al256(WS_W2 + (size_t)8 * 512 * 512 * 2);
constexpr size_t WS_HMOD = al256(WS_W3 + (size_t)1024 * 2048 * 2);
constexpr size_t BUFSZ = (size_t)TH * E * 2;
constexpr size_t WS_B0 = al256(WS_HMOD + (size_t)2 * TH * D * 2);
constexpr size_t WS_END = WS_B0 + 6 * BUFSZ;
static_assert(WS_END <= ((size_t)512 << 20), "workspace overflow");

constexpr int QROW = 1040;
constexpr int KROW = 1088;
constexpr int L_QS = 0, L_KS = 64 * QROW;
constexpr int L_SARR = 64 * QROW + 64 * KROW;
constexpr int L_SDEN = L_SARR + 2 * 5 * 256;
constexpr int L_ROWREC = L_SDEN + 2048 + 256 + 16;
constexpr int L_VS = L_ROWREC + 1024;
constexpr int L_XCH = L_VS + 8192;
constexpr int L_BARW = 163824;
constexpr int LDS_BYTES = L_BARW + 16;
static_assert(LDS_BYTES <= 160 * 1024 && L_XCH + 8192 <= L_BARW, "LDS overflow");

#define XB_TMO      128
#define XB_XCNT(j)  (256  + 64 * (j))
#define XB_XSUB(j)  (1280 + 64 * (j))
#define XB_XGEN(j)  (2304 + 64 * (j))
#define XB_TOP      3328
#define XB_TOPGEN   3392
#define XCD_BAR_WORDS 3456
#define XB_SPIN_CAP (1u << 22)

__device__ __forceinline__ unsigned xb_ld(unsigned* p)              { return __hip_atomic_load(p, __ATOMIC_RELAXED, __HIP_MEMORY_SCOPE_AGENT); }
__device__ __forceinline__ unsigned xb_add(unsigned* p, unsigned v) { return __hip_atomic_fetch_add(p, v, __ATOMIC_RELAXED, __HIP_MEMORY_SCOPE_AGENT); }
__device__ __forceinline__ unsigned xb_xcc_id() { return (unsigned)__builtin_amdgcn_s_getreg((3 << 11) | 20) & 0xFu; }
#define XB_SPIN(cond, bar) do { unsigned _sp = 0; while (cond) { __builtin_amdgcn_s_sleep(1); \
    if ((++_sp & 255u) == 0u) { if (xb_ld(&(bar)[XB_TMO])) break; if (_sp > XB_SPIN_CAP) { atomicAdd(&(bar)[XB_TMO], 1u); break; } } } } while (0)

struct XcdBarrier { unsigned* bar; unsigned x; volatile LAS unsigned* st; };

__device__ __forceinline__ XcdBarrier xcd_barrier_post(unsigned* bar, volatile LAS unsigned* st) {
    XcdBarrier b; b.bar = bar; b.x = xb_xcc_id(); b.st = st;
    if (threadIdx.x == 0) (void)xb_add(&bar[XB_XCNT(b.x)], 1u);
    return b;
}
__device__ __forceinline__ void xcd_barrier_complete(unsigned* bar, unsigned x, unsigned& nloc, unsigned& nx) {
    const unsigned G = gridDim.x * gridDim.y * gridDim.z;
    unsigned sum, cnt, mine, sp = 0u;
    for (;;) {
        sum = 0u; cnt = 0u; mine = 0u;
#pragma unroll
        for (unsigned j = 0; j < 16; ++j) { const unsigned c = xb_ld(&bar[XB_XCNT(j)]); sum += c; cnt += (c > 0u) ? 1u : 0u; mine = (j == x) ? c : mine; }
        if (sum == G) break;
        __builtin_amdgcn_s_sleep(1);
        if ((++sp & 255u) == 0u) { if (xb_ld(&bar[XB_TMO])) break; if (sp > XB_SPIN_CAP) { atomicAdd(&bar[XB_TMO], 1u); break; } }
    }
    nloc = mine > 0u ? mine : 1u; nx = cnt > 0u ? cnt : 1u;
}
template <bool FIRST>
__device__ __forceinline__ void xcd_barrier(const XcdBarrier& b) {
    asm volatile("s_waitcnt vmcnt(0)" ::: "memory");
    __syncthreads();
    if (threadIdx.x == 0) {
        unsigned* bar = b.bar;
        __builtin_amdgcn_s_waitcnt(0);
        unsigned nloc = b.st[0], nx = b.st[1];
        if (FIRST) { if (nloc == 0u) { xcd_barrier_complete(bar, b.x, nloc, nx); b.st[0] = nloc; b.st[1] = nx; } }
        const unsigned old = xb_add(&bar[XB_XSUB(b.x)], 1u);
        const unsigned gen = old / nloc;
        if (old + 1u == (gen + 1u) * nloc) {
            __builtin_amdgcn_fence(__ATOMIC_RELEASE, "agent");
            asm volatile("s_waitcnt vmcnt(0)" ::: "memory");
            const unsigned og = xb_add(&bar[XB_TOP], 1u);
            const unsigned tg = og / nx;
            if (og + 1u == (tg + 1u) * nx) xb_add(&bar[XB_TOPGEN], 1u);
            else XB_SPIN(xb_ld(&bar[XB_TOPGEN]) == tg, bar);
            __builtin_amdgcn_fence(__ATOMIC_ACQUIRE, "agent");
            xb_add(&bar[XB_XGEN(b.x)], 1u);
            asm volatile("s_waitcnt vmcnt(0)" ::: "memory");
        } else {
            XB_SPIN(xb_ld(&bar[XB_XGEN(b.x)]) == gen, bar);
            __builtin_amdgcn_fence(__ATOMIC_ACQUIRE, "agent");
            asm volatile("s_waitcnt vmcnt(0)" ::: "memory");
        }
    }
    __syncthreads();
}

typedef float f32x2 __attribute__((ext_vector_type(2)));
typedef __bf16 bf16x2_t __attribute__((ext_vector_type(2)));
__device__ __forceinline__ unsigned pack2(float lo, float hi) { const f32x2 f = {lo, hi}; const bf16x2_t h = __builtin_convertvector(f, bf16x2_t); return __builtin_bit_cast(unsigned, h); }
__device__ __forceinline__ bf16_t f2bf(float f) { return (bf16_t)(pack2(f, 0.f) & 0xffffu); }
__device__ __forceinline__ float bf2f(bf16_t b) { return __uint_as_float(((unsigned)b) << 16); }
__device__ __forceinline__ float silu_f(float v) { return v / (1.0f + __expf(-v)); }
__device__ __forceinline__ float sigmoid_f(float v) { return 1.0f / (1.0f + __expf(-v)); }
__device__ __forceinline__ float bfw(const unsigned (&w)[4], int i) { return bf2f((bf16_t)((i & 1) ? (w[i >> 1] >> 16) : (w[i >> 1] & 0xffffu))); }
#define DPP_F(v, ctrl, rmask, bc) __builtin_bit_cast(float, __builtin_amdgcn_update_dpp(0, __builtin_bit_cast(int, (v)), (ctrl), (rmask), 0xf, (bc)))
__device__ __forceinline__ float wave_sum(float v) {
    v += DPP_F(v, 0xB1, 0xf, true); v += DPP_F(v, 0x4E, 0xf, true); v += DPP_F(v, 0x141, 0xf, true); v += DPP_F(v, 0x140, 0xf, true);
    const int iv = __builtin_bit_cast(int, v);
    return (__builtin_bit_cast(float, __builtin_amdgcn_readlane(iv, 0)) + __builtin_bit_cast(float, __builtin_amdgcn_readlane(iv, 16)))
         + (__builtin_bit_cast(float, __builtin_amdgcn_readlane(iv, 32)) + __builtin_bit_cast(float, __builtin_amdgcn_readlane(iv, 48)));
}
__device__ __forceinline__ float wave_scan_sum(float v) {
    v += DPP_F(v, 0x111, 0xf, true); v += DPP_F(v, 0x112, 0xf, true); v += DPP_F(v, 0x114, 0xf, true); v += DPP_F(v, 0x118, 0xf, true);
    v += DPP_F(v, 0x142, 0xa, false); v += DPP_F(v, 0x143, 0xc, false);
    return v;
}
#define DPP_FM(v, ctrl, rmask) __builtin_bit_cast(float, __builtin_amdgcn_update_dpp((int)0xff800000, __builtin_bit_cast(int, (v)), (ctrl), (rmask), 0xf, false))
__device__ __forceinline__ float wave_scan_max(float v) {
    v = fmaxf(v, DPP_FM(v, 0x111, 0xf)); v = fmaxf(v, DPP_FM(v, 0x112, 0xf)); v = fmaxf(v, DPP_FM(v, 0x114, 0xf)); v = fmaxf(v, DPP_FM(v, 0x118, 0xf));
    v = fmaxf(v, DPP_FM(v, 0x142, 0xa)); v = fmaxf(v, DPP_FM(v, 0x143, 0xc));
    return v;
}
__device__ __forceinline__ int opq_tid() { int t = threadIdx.x; asm volatile("" : "+v"(t)); return t; }

struct Params {
    const float* x; const float* c; const float* ctx; const float* c_ctx; const float* norm_g; const float* w_ada; const float* b_ada;
    const float* m_w_in; const float* m_conv_w; const float* m_conv_b; const float* m_w_q; const float* m_w_k; const float* m_w_if;
    const float* m_b_i; const float* m_b_f; const float* m_ln_w; const float* m_skip; const float* m_w_out; const float* f_w_in; const float* f_w_out;
    const float* norm_f; float* out; unsigned char* ws; int ph_lo; int ph_hi;
};

struct GSeg { const void* A; const void* B; int K; };
template <typename T> __device__ __forceinline__ void load8_bf16(const T* p, unsigned (&w)[4]);
template <> __device__ __forceinline__ void load8_bf16<float>(const float* p, unsigned (&w)[4]) {
    const float4 a = *(const float4*)p, b = *(const float4*)(p + 4);
    w[0] = pack2(a.x, a.y); w[1] = pack2(a.z, a.w); w[2] = pack2(b.x, b.y); w[3] = pack2(b.z, b.w);
}
template <> __device__ __forceinline__ void load8_bf16<bf16_t>(const bf16_t* p, unsigned (&w)[4]) {
    const uint4 a = *(const uint4*)p; w[0] = a.x; w[1] = a.y; w[2] = a.z; w[3] = a.w;
}
template <typename TA, typename TB, int NSEG, class Epi, bool BCOL2 = false>
__device__ __forceinline__ void gemm_generic(LAS unsigned char* lds, const GSeg (&seg)[NSEG], size_t lda, size_t ldb, int M, int N, int nbatch, size_t sA, size_t sB, const Epi& epi) {
    const int tid = opq_tid(), lane = tid & 63, w = tid >> 6, fr = lane & 15, fq = lane >> 4, wm = w >> 2, wn = w & 3;
    LAS unsigned char* As = lds; LAS unsigned char* Bs = lds + 128 * 80;
    const int tm = M / 128, tn = N / 128, ntile = nbatch * tm * tn;
    const int arow = tid >> 2, ac8 = (tid & 3) * 8, bk = tid >> 4, bn8 = (tid & 15) * 8;
    for (int tile = blockIdx.x; tile < ntile; tile += gridDim.x) {
        const int batch = tile / (tm * tn), rem = tile % (tm * tn), m0 = (rem / tn) * 128, n0 = (rem % tn) * 128;
        f32x4 acc[4][2];
#pragma unroll
        for (int i = 0; i < 4; ++i)
#pragma unroll
            for (int j = 0; j < 2; ++j) acc[i][j] = (f32x4){0.f, 0.f, 0.f, 0.f};
#pragma unroll
        for (int sg = 0; sg < NSEG; ++sg) {
            const TA* Ab = (const TA*)seg[sg].A + batch * sA + (size_t)(m0 + arow) * lda + ac8;
            const TB* Bb = (const TB*)seg[sg].B + batch * sB + (size_t)bk * ldb + (BCOL2 ? 2 : 1) * (n0 + bn8);
            for (int k0 = 0; k0 < seg[sg].K; k0 += 32) {
                unsigned aw[4], bw[4];
                load8_bf16<TA>(Ab + k0, aw);
                load8_bf16<TB>(Bb + (size_t)k0 * ldb, bw);
                __syncthreads();
                *(LAS u32x4*)(As + arow * 80 + ac8 * 2) = (u32x4){aw[0], aw[1], aw[2], aw[3]};
#pragma unroll
                for (int i = 0; i < 4; ++i) {
                    *(LAS bf16_t*)(Bs + (bn8 + 2 * i) * 80 + bk * 2) = (bf16_t)(bw[i] & 0xffffu);
                    *(LAS bf16_t*)(Bs + (bn8 + 2 * i + 1) * 80 + bk * 2) = (bf16_t)(bw[i] >> 16);
                }
                __syncthreads();
                bf16x8 af[4], bfr[2];
#pragma unroll
                for (int i = 0; i < 4; ++i) af[i] = *(const LAS bf16x8*)(As + (wm * 64 + i * 16 + fr) * 80 + fq * 16);
#pragma unroll
                for (int j = 0; j < 2; ++j) bfr[j] = *(const LAS bf16x8*)(Bs + (wn * 32 + j * 16 + fr) * 80 + fq * 16);
#pragma unroll
                for (int i = 0; i < 4; ++i)
#pragma unroll
                    for (int j = 0; j < 2; ++j) acc[i][j] = __builtin_amdgcn_mfma_f32_16x16x32_bf16(af[i], bfr[j], acc[i][j], 0, 0, 0);
            }
        }
#pragma unroll
        for (int i = 0; i < 4; ++i)
#pragma unroll
            for (int j = 0; j < 2; ++j)
#pragma unroll
                for (int r = 0; r < 4; ++r) epi(batch, m0 + wm * 64 + i * 16 + fq * 4 + r, n0 + wn * 32 + j * 16 + fr, acc[i][j][r]);
    }
    __syncthreads();
}


namespace pg8 {
constexpr int BM = 256, BK = 64, HALF = 128, HTB = HALF * BK * 2, NXCD = 8, WGM = 8;
__device__ __forceinline__ int lds_byte(int r, int c) { const int st = (r >> 4) * 2 + (c >> 5), rr = r & 15, cc = c & 31, ob = rr * 64 + cc * 2; return st * 1024 + (ob ^ (((ob >> 9) & 1) << 5)); }
__device__ __forceinline__ void stage_rc(int b, int& R, int& C) { const int st = b / 1024, sb = b % 1024, swz = sb ^ (((sb >> 9) & 1) << 5); R = (st >> 1) * 16 + swz / 64; C = (st & 1) * 32 + (swz % 64) / 2; }
__device__ __forceinline__ int perm32(int rho) { const int n = rho >> 4, i = rho & 15; return 8 * (i >> 2) + 4 * n + (i & 3); }
struct Unit { int pm, pn, b; };
struct Gemm { const bf16_t* A; const bf16_t* Bt; int M, N, K, lda, ldb, nb, nbA; size_t sAb, sBb; int diag; int bh_rows, bt_rows; };
struct Order {
    int nM, nN, nwg, G, c;
    __device__ void init(int M, int N, int nb, int G_, int c_) { nM = M / BM; nN = N / BM; nwg = nb * nM * nN; G = G_; c = c_; }
    __device__ bool next(int i, Unit& u) const {
        const long L = (long)i * G + c; if (L >= nwg) return false;
        int wgid = (int)L; { const int q = nwg / NXCD, r = nwg % NXCD, xcd = wgid % NXCD, off = wgid / NXCD; wgid = (xcd < r ? xcd * (q + 1) : r * (q + 1) + (xcd - r) * q) + off; }
        const int nMv = nwg / nN, nig = WGM * nN, gid = wgid / nig, fm = gid * WGM, gsz = (nMv - fm) < WGM ? (nMv - fm) : WGM;
        const int vm = fm + ((wgid % nig) % gsz); u.pn = (wgid % nig) / gsz; u.b = vm / nM; u.pm = vm % nM; return true;
    }
};
__device__ __forceinline__ unsigned cvt_pk_bf16(float lo, float hi) { unsigned r; asm volatile("v_cvt_pk_bf16_f32 %0, %1, %2" : "=v"(r) : "v"(lo), "v"(hi)); return r; }

template <class Epi>
__device__ __forceinline__ void gemm_phase(LAS unsigned char* lds, const Gemm g, const Order& S, const Epi& E) {
    const int tid = opq_tid(), wid = __builtin_amdgcn_readfirstlane(tid >> 6), lane = tid & 63, wr = wid >> 2, wc = wid & 3, fr = lane & 15, fq = lane >> 4;
    const int K = g.K, nt = K / BK;
    unsigned voffA[2], voffB[2];
#pragma unroll
    for (int i = 0; i < 2; ++i) { int R, C; stage_rc(tid * 16 + i * 8192, R, C); const int Rb = Epi::PERM ? ((R & ~31) + perm32(R & 31)) : R;
        voffA[i] = (unsigned)(R * g.lda + C) * 2u; voffB[i] = (unsigned)(Rb * g.ldb + C) * 2u; }
    const size_t kstep = (size_t)(BK * 2);
    const size_t hstepA = (size_t)HALF * g.lda * 2, hstepB = (size_t)(g.bh_rows ? g.bh_rows : HALF) * g.ldb * 2;
    const size_t tstepA = 2 * hstepA, tstepB = (size_t)(g.bt_rows ? g.bt_rows : 2 * HALF) * g.ldb * 2;
    const unsigned ldsw = (unsigned)wid * 1024u;
    const int aoff = lds_byte(wr * 64 + fr, fq * 8), boff = lds_byte(wc * 32 + fr, fq * 8);
#define PG8_SA(b, h) (((b) * 2 + (h)) * HTB)
#define PG8_SB(b, h) ((4 + (b) * 2 + (h)) * HTB)
#define PG8_STAGE(bufoff, gbase, voff) do { _Pragma("unroll") for (int _i = 0; _i < 2; ++_i) \
        __builtin_amdgcn_global_load_lds((const unsigned*)((const char*)(gbase) + (voff)[_i]), (LAS unsigned*)(lds + (bufoff) + ldsw + _i * 8192), 16, 0, 0); } while (0)
#define PG8_LDA(dst, b, h) do { _Pragma("unroll") for (int m = 0; m < 4; ++m) _Pragma("unroll") for (int k = 0; k < 2; ++k) dst[m][k] = *(const LAS bf16x8*)(lds + PG8_SA(b, h) + aoff + m * 2048 + k * 1024); } while (0)
#define PG8_LDB(dst, b, h) do { _Pragma("unroll") for (int n = 0; n < 2; ++n) _Pragma("unroll") for (int k = 0; k < 2; ++k) dst[n][k] = *(const LAS bf16x8*)(lds + PG8_SB(b, h) + boff + n * 2048 + k * 1024); } while (0)
#define PG8_MMA(ai, bj, At, Bt) do { __builtin_amdgcn_s_setprio(1); _Pragma("unroll") for (int m = 0; m < 4; ++m) _Pragma("unroll") for (int n = 0; n < 2; ++n) _Pragma("unroll") for (int k = 0; k < 2; ++k) \
        acc[ai][bj][m][n] = __builtin_amdgcn_mfma_f32_16x16x32_bf16(Bt[n][k], At[m][k], acc[ai][bj][m][n], 0, 0, 0); __builtin_amdgcn_s_setprio(0); } while (0)
#define PG8_WAIT_V(n) asm volatile("s_waitcnt vmcnt(" #n ")" ::: "memory")
#define PG8_WAIT_L(n) asm volatile("s_waitcnt lgkmcnt(" #n ")" ::: "memory")
#define PG8_WAIT_VE do { if (Epi::NVM == 16) asm volatile("s_waitcnt vmcnt(22)" ::: "memory"); else if (Epi::NVM == 8) asm volatile("s_waitcnt vmcnt(14)" ::: "memory"); else if (Epi::NVM == 32) asm volatile("s_waitcnt vmcnt(38)" ::: "memory"); else asm volatile("s_waitcnt vmcnt(6)" ::: "memory"); } while (0)
#define PG8_BAR __builtin_amdgcn_s_barrier()
#define PG8_SCHED __builtin_amdgcn_sched_barrier(0)
#define PG8_KSTEP(t, PRE) do { \
            const bool last = ((t) == nt - 2); \
            const char* a1 = cA + (size_t)((t) + 1) * kstep; \
            const char* a2 = last ? nA : cA + (size_t)((t) + 2) * kstep; const char* b2 = last ? nB : cB + (size_t)((t) + 2) * kstep; \
            const char* a3 = a2 + kstep; const char* b3 = b2 + kstep; \
            PG8_LDB(B0, 0, 0); PG8_SCHED; PG8_LDA(At, 0, 0); if (!(PRE)) PG8_STAGE(PG8_SA(1, 1), a1 + hstepA, voffA); \
            PG8_WAIT_L(8); PG8_BAR; PG8_WAIT_L(0); PG8_MMA(0, 0, At, B0); PG8_BAR; PG8_SCHED; \
            PG8_LDB(B1, 0, 1); PG8_STAGE(PG8_SB(0, 0), b2, voffB); \
            PG8_BAR; PG8_WAIT_L(0); if (!g.diag) PG8_MMA(0, 1, At, B1); PG8_BAR; \
            PG8_LDA(At, 0, 1); PG8_STAGE(PG8_SA(0, 0), a2, voffA); \
            PG8_BAR; PG8_WAIT_L(0); if (!g.diag) PG8_MMA(1, 0, At, B0); PG8_BAR; PG8_SCHED; \
            PG8_STAGE(PG8_SB(0, 1), b2 + hstepB, voffB); \
            if (PRE) PG8_WAIT_VE; else PG8_WAIT_V(6); PG8_BAR; PG8_MMA(1, 1, At, B1); PG8_BAR; \
            PG8_LDB(B0, 1, 0); PG8_SCHED; PG8_LDA(At, 1, 0); PG8_STAGE(PG8_SA(0, 1), a2 + hstepA, voffA); \
            PG8_WAIT_L(8); PG8_BAR; PG8_WAIT_L(0); PG8_MMA(0, 0, At, B0); PG8_BAR; PG8_SCHED; \
            PG8_LDB(B1, 1, 1); PG8_STAGE(PG8_SB(1, 0), b3, voffB); \
            PG8_BAR; PG8_WAIT_L(0); if (!g.diag) PG8_MMA(0, 1, At, B1); PG8_BAR; \
            PG8_LDA(At, 1, 1); PG8_STAGE(PG8_SA(1, 0), a3, voffA); \
            PG8_BAR; PG8_WAIT_L(0); if (!g.diag) PG8_MMA(1, 0, At, B0); PG8_BAR; PG8_SCHED; \
            PG8_STAGE(PG8_SB(1, 1), b3 + hstepB, voffB); \
            PG8_WAIT_V(6); PG8_BAR; PG8_MMA(1, 1, At, B1); PG8_BAR; } while (0)
#define PG8_ZERO_ACC do { _Pragma("unroll") for (int a = 0; a < 2; ++a) _Pragma("unroll") for (int b = 0; b < 2; ++b) _Pragma("unroll") for (int m = 0; m < 4; ++m) \
        _Pragma("unroll") for (int n = 0; n < 2; ++n) { acc[a][b][m][n] = (f32x4){0.f, 0.f, 0.f, 0.f}; asm volatile("" : "+v"(acc[a][b][m][n])); } } while (0)
#define PG8_NEXT_PTRS do { has_next = S.next(ui + 1, nxt); \
        nA = has_next ? (const char*)(g.A + (size_t)(nxt.b % g.nbA) * g.sAb) + (size_t)nxt.pm * tstepA : cA; \
        nB = has_next ? (const char*)(g.Bt + (size_t)nxt.b * g.sBb) + (size_t)(g.diag ? nxt.pm : nxt.pn) * tstepB : cB; } while (0)
    Unit cur, nxt; int ui = 0;
    if (!S.next(0, cur)) return;
    f32x4 acc[2][2][4][2];
    PG8_ZERO_ACC;
    bf16x8 At[4][2], B0[2][2], B1[2][2];
    const char* cA = (const char*)(g.A + (size_t)(cur.b % g.nbA) * g.sAb) + (size_t)cur.pm * tstepA; const char* cB = (const char*)(g.Bt + (size_t)cur.b * g.sBb) + (size_t)(g.diag ? cur.pm : cur.pn) * tstepB;
    PG8_STAGE(PG8_SB(0, 0), cB, voffB); PG8_STAGE(PG8_SA(0, 0), cA, voffA); PG8_STAGE(PG8_SB(0, 1), cB + hstepB, voffB); PG8_STAGE(PG8_SA(0, 1), cA + hstepA, voffA);
    if (wr == 1) PG8_BAR;
    PG8_WAIT_V(4); PG8_BAR;
    PG8_STAGE(PG8_SB(1, 0), cB + kstep, voffB); PG8_STAGE(PG8_SA(1, 0), cA + kstep, voffA); PG8_STAGE(PG8_SB(1, 1), cB + hstepB + kstep, voffB);
    PG8_WAIT_V(6); PG8_BAR;
    bool has_next; const char* nA; const char* nB;
    PG8_NEXT_PTRS;
    for (int t = 0; t < nt; t += 2) PG8_KSTEP(t, false);
    for (;;) {
        if (Epi::NVM > 0) { PG8_STAGE(PG8_SA(1, 1), nA + kstep + hstepA, voffA); PG8_SCHED; }
        E(acc, cur, wr, wc, fr, fq);
        PG8_SCHED;
        if (!has_next) break;
        PG8_ZERO_ACC;
        cur = nxt; cA = nA; cB = nB; ++ui;
        PG8_NEXT_PTRS;
        if (Epi::NVM > 0) { PG8_KSTEP(0, true); for (int t = 2; t < nt; t += 2) PG8_KSTEP(t, false); }
        else { for (int t = 0; t < nt; t += 2) PG8_KSTEP(t, false); }
    }
    PG8_WAIT_V(0);
    if (wr == 0) PG8_BAR;
    PG8_BAR;
#undef PG8_SA
#undef PG8_SB
#undef PG8_STAGE
#undef PG8_LDA
#undef PG8_LDB
#undef PG8_MMA
#undef PG8_WAIT_V
#undef PG8_WAIT_L
#undef PG8_WAIT_VE
#undef PG8_KSTEP
#undef PG8_ZERO_ACC
#undef PG8_NEXT_PTRS
#undef PG8_BAR
#undef PG8_SCHED
}
struct EpiBf16 {
    static constexpr bool PERM = true; static constexpr int NVM = 16;
    bf16_t* O0; bf16_t* O1; int nb0; int bcols; size_t ldc; float s0, s1;
    __device__ __forceinline__ void operator()(const f32x4 (&acc)[2][2][4][2], const Unit& u, int wr, int wc, int fr, int fq) const {
        const bool second = u.b >= nb0; bf16_t* O = second ? O1 : O0; const float sc = second ? s1 : s0; const int bb = second ? u.b - nb0 : u.b;
        const int row0 = u.pm * BM + wr * 64 + fr, col0 = bb * bcols + u.pn * BM + wc * 32 + 8 * fq;
#pragma unroll
        for (int ai = 0; ai < 2; ++ai)
#pragma unroll
            for (int m = 0; m < 4; ++m) { bf16_t* rowp = O + (size_t)(row0 + ai * HALF + m * 16) * ldc + col0;
#pragma unroll
                for (int bj = 0; bj < 2; ++bj) { const f32x4 v0 = acc[ai][bj][m][0] * sc, v1 = acc[ai][bj][m][1] * sc;
                    u32x4 w; w.x = cvt_pk_bf16(v0[0], v0[1]); w.y = cvt_pk_bf16(v0[2], v0[3]); w.z = cvt_pk_bf16(v1[0], v1[1]); w.w = cvt_pk_bf16(v1[2], v1[3]);
                    *(u32x4*)(rowp + bj * HALF) = w; } }
    }
};
struct EpiSplitOZ {
    static constexpr bool PERM = true; static constexpr int NVM = 16;
    bf16_t* O0; bf16_t* O1;
    __device__ __forceinline__ void operator()(const f32x4 (&acc)[2][2][4][2], const Unit& u, int wr, int wc, int fr, int fq) const {
        const int ct = u.pn * BM; bf16_t* O = (ct < E) ? O0 : O1; const int row0 = u.pm * BM + wr * 64 + fr, col0 = (ct & (E - 1)) + wc * 32 + 8 * fq;
#pragma unroll
        for (int ai = 0; ai < 2; ++ai)
#pragma unroll
            for (int m = 0; m < 4; ++m) { bf16_t* rowp = O + (size_t)(row0 + ai * HALF + m * 16) * E + col0;
#pragma unroll
                for (int bj = 0; bj < 2; ++bj) { const f32x4 v0 = acc[ai][bj][m][0], v1 = acc[ai][bj][m][1];
                    u32x4 w; w.x = cvt_pk_bf16(v0[0], v0[1]); w.y = cvt_pk_bf16(v0[2], v0[3]); w.z = cvt_pk_bf16(v1[0], v1[1]); w.w = cvt_pk_bf16(v1[2], v1[3]);
                    *(u32x4*)(rowp + bj * HALF) = w; } }
    }
};
struct EpiMout {
    static constexpr bool PERM = true; static constexpr int NVM = 8;
    const bf16_t* Hf; const bf16_t* Hr; const bf16_t* XCV; const float* stats; const float* lnw; const float* skp; bf16_t* Y;
    __device__ __forceinline__ void operator()(f32x4 (&acc)[2][2][4][2], const Unit& u, int wr, int wc, int fr, int fq) const {
        const int f0 = u.pn * HALF + wc * 32 + 8 * fq, head = f0 >> 9, row0 = u.pm * BM + wr * 64 + fr;
        const f32x4 lw0 = *(const f32x4*)(lnw + f0), lw1 = *(const f32x4*)(lnw + f0 + 4), sk0 = *(const f32x4*)(skp + f0), sk1 = *(const f32x4*)(skp + f0 + 4);
        u32x4 a[4], b[4], xv[4]; f32x2 st[4]; u32x4 yo[4];
#define EM_LOAD(ai) do { _Pragma("unroll") for (int m = 0; m < 4; ++m) { const int row = row0 + (ai) * HALF + m * 16; const size_t off = (size_t)row * E + f0; \
            a[m] = *(const u32x4*)(Hf + off); b[m] = *(const u32x4*)(Hr + off); xv[m] = *(const u32x4*)(XCV + off); st[m] = *(const f32x2*)(stats + ((size_t)row * NH + head) * 2); } } while (0)
#define EM_GATE(ai) do { _Pragma("unroll") for (int m = 0; m < 4; ++m) _Pragma("unroll") for (int n = 0; n < 2; ++n) _Pragma("unroll") for (int e = 0; e < 4; ++e) { \
            acc[ai][0][m][n][e] = sigmoid_f(acc[ai][0][m][n][e]); acc[ai][1][m][n][e] = silu_f(acc[ai][1][m][n][e]); } } while (0)
#define EM_COMB(ai) do { _Pragma("unroll") for (int m = 0; m < 4; ++m) { \
            const unsigned aw[4] = {a[m].x, a[m].y, a[m].z, a[m].w}, bw[4] = {b[m].x, b[m].y, b[m].z, b[m].w}, xw[4] = {xv[m].x, xv[m].y, xv[m].z, xv[m].w}; \
            const f32x4 o0 = acc[ai][0][m][0], o1 = acc[ai][0][m][1], z0 = acc[ai][1][m][0], z1 = acc[ai][1][m][1]; float y[8]; \
            _Pragma("unroll") for (int i = 0; i < 8; ++i) { const float so = (i < 4) ? o0[i & 3] : o1[i & 3], sz = (i < 4) ? z0[i & 3] : z1[i & 3], lw = (i < 4) ? lw0[i & 3] : lw1[i & 3], sk = (i < 4) ? sk0[i & 3] : sk1[i & 3]; \
                const float hn = (bfw(aw, i) + bfw(bw, i) - st[m][0]) * st[m][1] * lw * so; y[i] = (hn + sk * bfw(xw, i)) * sz; } \
            yo[m].x = cvt_pk_bf16(y[0], y[1]); yo[m].y = cvt_pk_bf16(y[2], y[3]); yo[m].z = cvt_pk_bf16(y[4], y[5]); yo[m].w = cvt_pk_bf16(y[6], y[7]); } } while (0)
#define EM_STORE(ai) do { _Pragma("unroll") for (int m = 0; m < 4; ++m) { const int row = row0 + (ai) * HALF + m * 16; *(u32x4*)(Y + (size_t)row * E + f0) = yo[m]; } } while (0)
        EM_LOAD(0); __builtin_amdgcn_sched_barrier(0); EM_GATE(0); __builtin_amdgcn_sched_barrier(0); EM_COMB(0);
        __builtin_amdgcn_sched_barrier(0); EM_LOAD(1); __builtin_amdgcn_sched_barrier(0); EM_STORE(0); __builtin_amdgcn_sched_barrier(0);
        EM_GATE(1); __builtin_amdgcn_sched_barrier(0); EM_COMB(1); EM_STORE(1);
#undef EM_LOAD
#undef EM_GATE
#undef EM_COMB
#undef EM_STORE
    }
};
template <bool SRCF>
struct EpiResid {
    static constexpr bool PERM = true; static constexpr int NVM = 16;
    const float* xlat_f; const float* xctx_f; bf16_t* xlat; bf16_t* xctx; const float* mods_layer; int b0; int tlat;
    __device__ __forceinline__ void operator()(const f32x4 (&acc)[2][2][4][2], const Unit& u, int wr, int wc, int fr, int fq) const {
        const int rt = u.pm * BM, col0 = u.pn * BM + wc * 32 + 8 * fq;
        const bool lat = rt < tlat; const int b = b0 + (lat ? (rt >> 12) : ((rt - tlat) >> 8));
        const int r0 = (lat ? (rt & 4095) : 0) + wr * 64 + fr;
        const float* gv = mods_layer + (size_t)(lat ? b : 8) * 3072 + 2048 + col0;
        const f32x4 g00 = *(const f32x4*)(gv), g01 = *(const f32x4*)(gv + 4), g10 = *(const f32x4*)(gv + HALF), g11 = *(const f32x4*)(gv + HALF + 4);
        const size_t rbase = lat ? (size_t)b * SEQ : (size_t)b * CTX;
        const float* sf = (lat ? xlat_f : xctx_f) + (rbase + r0) * D + col0;
        bf16_t* sb = lat ? (xlat + (rbase + r0) * (2 * D) + col0) : (xctx + (rbase + r0) * D + col0);
        const size_t rsb = lat ? (size_t)2 * D : (size_t)D;
#pragma unroll
        for (int ai = 0; ai < 2; ++ai) {
            f32x4 xf[4][2][2]; u32x4 xb[4][2];
#pragma unroll
            for (int m = 0; m < 4; ++m) { const int dr = ai * HALF + m * 16;
#pragma unroll
                for (int bj = 0; bj < 2; ++bj) {
                    if (SRCF) { xf[m][bj][0] = *(const f32x4*)(sf + (size_t)dr * D + bj * HALF); xf[m][bj][1] = *(const f32x4*)(sf + (size_t)dr * D + bj * HALF + 4); }
                    else xb[m][bj] = *(const u32x4*)(sb + dr * rsb + bj * HALF); } }
            __builtin_amdgcn_sched_barrier(0);
#pragma unroll
            for (int m = 0; m < 4; ++m) { const int dr = ai * HALF + m * 16;
#pragma unroll
                for (int bj = 0; bj < 2; ++bj) { f32x4 x0, x1;
                    if (SRCF) { x0 = xf[m][bj][0]; x1 = xf[m][bj][1]; }
                    else { const u32x4 xw = xb[m][bj];
                        x0 = (f32x4){__uint_as_float(xw.x << 16), __uint_as_float(xw.x & 0xffff0000u), __uint_as_float(xw.y << 16), __uint_as_float(xw.y & 0xffff0000u)};
                        x1 = (f32x4){__uint_as_float(xw.z << 16), __uint_as_float(xw.z & 0xffff0000u), __uint_as_float(xw.w << 16), __uint_as_float(xw.w & 0xffff0000u)}; }
                    const f32x4 v0 = x0 + (bj ? g10 : g00) * acc[ai][bj][m][0], v1 = x1 + (bj ? g11 : g01) * acc[ai][bj][m][1];
                    u32x4 w; w.x = cvt_pk_bf16(v0[0], v0[1]); w.y = cvt_pk_bf16(v0[2], v0[3]); w.z = cvt_pk_bf16(v1[0], v1[1]); w.w = cvt_pk_bf16(v1[2], v1[3]);
                    *(u32x4*)(sb + dr * rsb + bj * HALF) = w; } }
        }
    }
};
struct EpiSdiag {
    static constexpr bool PERM = true; static constexpr int NVM = 0;
    bf16_t* S; bf16_t* R;
    __device__ __forceinline__ void operator()(const f32x4 (&acc)[2][2][4][2], const Unit& u, int wr, int wc, int fr, int fq) const {
        if (wr != (wc >> 1)) return;
        const int bl = (u.pm < 64) ? (u.pm >> 4) : (u.pm - 64), ch0 = (u.pm < 64) ? (4 + (u.pm & 15) * 4) : 0;
        const int ss0 = (wc & 1) * 32 + 8 * fq;
#pragma unroll
        for (int ai = 0; ai < 2; ++ai) { const int ci = ch0 + 2 * ai + wr, cr = (ci < 4) ? (3 - ci) : (71 - ci);
            bf16_t* bf = S + ((size_t)((bl * NH + u.b) * 68 + ci) * 64) * 64; bf16_t* br = R + ((size_t)((bl * NH + u.b) * 68 + cr) * 64) * 64;
#pragma unroll
            for (int m = 0; m < 4; ++m) { const int jj = 16 * m + fr; const f32x4 v0 = acc[ai][ai][m][0], v1 = acc[ai][ai][m][1];
                const float v[8] = {v0[0], v0[1], v0[2], v0[3], v1[0], v1[1], v1[2], v1[3]};
                float f[8], r[8];
#pragma unroll
                for (int e = 0; e < 8; ++e) { f[e] = (ss0 + e <= jj) ? v[e] : 0.f; r[7 - e] = (ss0 + e >= jj) ? v[e] : 0.f; }
                u32x4 wf, wr_; wf.x = cvt_pk_bf16(f[0], f[1]); wf.y = cvt_pk_bf16(f[2], f[3]); wf.z = cvt_pk_bf16(f[4], f[5]); wf.w = cvt_pk_bf16(f[6], f[7]);
                wr_.x = cvt_pk_bf16(r[0], r[1]); wr_.y = cvt_pk_bf16(r[2], r[3]); wr_.z = cvt_pk_bf16(r[4], r[5]); wr_.w = cvt_pk_bf16(r[6], r[7]);
                *(u32x4*)(bf + (size_t)jj * 64 + ss0) = wf;
                *(u32x4*)(br + (size_t)(63 - jj) * 64 + (56 - ss0)) = wr_; } }
    }
};
}

__host__ __device__ __forceinline__ int fperm(int col) { const int g = col >> 8, c = col & 255;
    if (c < 128) return (g * 16 + (c >> 3)) * 16 + (c & 7);
    if (c == 128) return (g * 16) * 16 + 8;
    const int m = 256 - c; return (g * 16 + (m >> 3)) * 16 + 8 + (m & 7); }
template <int PERM_MODE = 0>
__device__ __forceinline__ void phase_transpose(LAS unsigned char* lds, const float* W, bf16_t* WT, int K, int N, size_t ldn, int nmat, size_t sW, size_t sWT, int bid, int nb) {
    LAS float* tl = (LAS float*)lds; const int tid = opq_tid();
    const int tk = K / 64, tn = N / 64, ntile = nmat * tk * tn;
    for (int tile = bid; tile < ntile; tile += nb) {
        const int mtx = tile / (tk * tn), rem = tile % (tk * tn), k0 = (rem / tn) * 64, n0 = (rem % tn) * 64;
        { const int r = tid >> 3, c8 = (tid & 7) * 8; const float* src = W + mtx * sW + (size_t)(k0 + r) * ldn + n0 + c8;
          const float4 a = *(const float4*)src, b = *(const float4*)(src + 4);
          __syncthreads();
          LAS float* d = tl + r * 65 + c8; d[0] = a.x; d[1] = a.y; d[2] = a.z; d[3] = a.w; d[4] = b.x; d[5] = b.y; d[6] = b.z; d[7] = b.w; }
        __syncthreads();
        { const int n = tid >> 3, k8 = (tid & 7) * 8; float v[8];
#pragma unroll
          for (int i = 0; i < 8; ++i) v[i] = tl[(k8 + i) * 65 + n];
          if (PERM_MODE == 2) {
#pragma unroll
              for (int i = 0; i < 8; ++i) WT[mtx * sWT + (size_t)(n0 + n) * K + fperm(k0 + k8 + i)] = f2bf(v[i]);
          } else { const int nr = (PERM_MODE == 1) ? fperm(n0 + n) : (n0 + n);
              *(uint4*)(WT + mtx * sWT + (size_t)nr * K + k0 + k8) = make_uint4(pack2(v[0], v[1]), pack2(v[2], v[3]), pack2(v[4], v[5]), pack2(v[6], v[7])); } }
    }
    __syncthreads();
}

struct EpiFold { bf16_t* W;
    __device__ __forceinline__ void operator()(int g, int row, int col, float v) const { const int cc = col & 127, ri = col >> 7; const int r = (g * 16 + (cc >> 3)) * 16 + ri * 8 + (cc & 7); W[(size_t)r * 1024 + row] = f2bf(v); } };
__device__ __forceinline__ void phase_mods(const Params& p, LAS unsigned char* lds) {
    LAS float* sl = (LAS float*)lds; LAS float* red = sl + 9 * 1024; const int tid = opq_tid(), lane = tid & 63, w = tid >> 6;
    for (int i = tid; i < 9 * 1024; i += NTHREADS) { const float v = (i < 8192) ? p.c[i] : p.c_ctx[i - 8192]; sl[i] = silu_f(v); }
    __syncthreads();
    float* mods = (float*)(p.ws + WS_MODS);
    for (int grp = blockIdx.x; grp < 4 * 48; grp += gridDim.x) {
        const int layer = grp / 48, col = (grp % 48) * 64 + lane;
        float acc[9];
#pragma unroll
        for (int v = 0; v < 9; ++v) acc[v] = 0.f;
        const float* wp = p.w_ada + ((size_t)layer * 1024 + w * 128) * 3072 + col;
#pragma unroll 8
        for (int k = 0; k < 128; ++k) { const float wv = wp[(size_t)k * 3072];
#pragma unroll
            for (int v = 0; v < 9; ++v) acc[v] += sl[v * 1024 + w * 128 + k] * wv; }
#pragma unroll
        for (int v = 0; v < 9; ++v) red[(w * 9 + v) * 64 + lane] = acc[v];
        __syncthreads();
        for (int o = tid; o < 9 * 64; o += NTHREADS) { const int v = o >> 6, l = o & 63; float sum = p.b_ada[layer * 3072 + (grp % 48) * 64 + l];
#pragma unroll
            for (int ww = 0; ww < 8; ++ww) sum += red[(ww * 9 + v) * 64 + l];
            mods[((size_t)layer * 9 + v) * 3072 + (grp % 48) * 64 + l] = sum; }
        __syncthreads();
    }
}
__device__ __forceinline__ void phase_tables(const Params& p) {
    float* Fc = (float*)(p.ws + WS_FC);
    const int gt = blockIdx.x * NTHREADS + opq_tid(), gs = gridDim.x * NTHREADS;
    for (int i = gt; i < 256 * 256; i += gs) { const int d = i >> 8, col = i & 255, cc = col & 127; const float a = (float)((d * cc) & 255) * (2.0f / 256.0f);
        float v; if (col < 128) v = cospif(a); else v = (cc == 0) ? ((d & 1) ? -1.0f : 1.0f) : -sinpif(a);
        Fc[i] = v * (1.0f / 16.0f); }
    bf16_t* Tc = (bf16_t*)(p.ws + WS_TCTX);
    for (int i = gt; i < 256 * 256; i += gs) { const int pp = i >> 8, n = i & 255; const float a = (float)((pp * n) & 255) * (2.0f / 256.0f);
        Tc[i] = f2bf(cospif(a) * (1.0f / 16.0f)); Tc[65536 + i] = f2bf(sinpif(a) * (1.0f / 16.0f)); }
}
__device__ __forceinline__ void conv_unpack(const uint4 xv, float (&x)[8]) {
    x[0] = __uint_as_float(xv.x << 16); x[1] = __uint_as_float(xv.x & 0xffff0000u); x[2] = __uint_as_float(xv.y << 16); x[3] = __uint_as_float(xv.y & 0xffff0000u);
    x[4] = __uint_as_float(xv.z << 16); x[5] = __uint_as_float(xv.z & 0xffff0000u); x[6] = __uint_as_float(xv.w << 16); x[7] = __uint_as_float(xv.w & 0xffff0000u);
}
__device__ __forceinline__ void phase_hmod(const Params& p, int layer, int b0, int tlat, int nrows, bf16_t* H, int bid, int nb) {
    const float* mods = (const float*)(p.ws + WS_MODS) + (size_t)layer * 9 * 3072; const float* ng = p.norm_g + layer * D;
    const bf16_t* xlb = (const bf16_t*)p.out; const bf16_t* xcb = (const bf16_t*)(p.ws + WS_XC);
    const int tid = opq_tid(), lane = tid & 63, gw = bid * 8 + (tid >> 6), nw = nb * 8;
    for (int r = gw; r < nrows; r += nw) {
        size_t gi; const float* mv; bool lat = r < tlat;
        if (lat) { const int b = b0 + (r >> 12); gi = (size_t)b * SEQ + (r & 4095); mv = mods + (size_t)b * 3072; }
        else { const int rc = r - tlat; const int b = b0 + (rc >> 8); gi = (size_t)b * CTX + (rc & 255); mv = mods + (size_t)8 * 3072; }
        float v[2][8]; float ss = 0.f;
        if (layer == 0) { const float* src = (lat ? p.x : p.ctx) + gi * D;
#pragma unroll
            for (int i = 0; i < 2; ++i) { const float4 a = *(const float4*)(src + i * 512 + lane * 8), b = *(const float4*)(src + i * 512 + lane * 8 + 4);
                v[i][0] = a.x; v[i][1] = a.y; v[i][2] = a.z; v[i][3] = a.w; v[i][4] = b.x; v[i][5] = b.y; v[i][6] = b.z; v[i][7] = b.w; }
        } else { const bf16_t* src = lat ? (xlb + gi * (2 * D)) : (xcb + gi * D);
#pragma unroll
            for (int i = 0; i < 2; ++i) { const uint4 a = *(const uint4*)(src + i * 512 + lane * 8); conv_unpack(a, v[i]); }
        }
#pragma unroll
        for (int i = 0; i < 2; ++i)
#pragma unroll
            for (int e = 0; e < 8; ++e) ss += v[i][e] * v[i][e];
        ss = wave_sum(ss);
        const float rs = rsqrtf(ss * (1.0f / D) + EPS);
#pragma unroll
        for (int i = 0; i < 2; ++i) { const int c0 = i * 512 + lane * 8; float o[8];
#pragma unroll
            for (int h = 0; h < 2; ++h) { const float4 g = *(const float4*)(ng + c0 + 4 * h), sh = *(const float4*)(mv + c0 + 4 * h), sc = *(const float4*)(mv + 1024 + c0 + 4 * h);
                o[4 * h + 0] = v[i][4 * h + 0] * rs * g.x * (1.f + sc.x) + sh.x; o[4 * h + 1] = v[i][4 * h + 1] * rs * g.y * (1.f + sc.y) + sh.y;
                o[4 * h + 2] = v[i][4 * h + 2] * rs * g.z * (1.f + sc.z) + sh.z; o[4 * h + 3] = v[i][4 * h + 3] * rs * g.w * (1.f + sc.w) + sh.w; }
            *(uint4*)(H + (size_t)r * D + c0) = make_uint4(pack2(o[0], o[1]), pack2(o[2], o[3]), pack2(o[4], o[5]), pack2(o[6], o[7])); }
    }
}
__device__ __forceinline__ void phase_conv(const Params& p, int j, const bf16_t* XM, bf16_t* XCV) {
    const float* cw = p.m_conv_w + (size_t)j * 9 * E; const float* cb = p.m_conv_b + (size_t)j * E;
    const int gt = blockIdx.x * NTHREADS + opq_tid(), gs = gridDim.x * NTHREADS;
    constexpr int NLAT = HB * 64 * 8 * 256, NCTX = HB * 32 * 256;
    float bs[8];
    { const int c8 = (gt & 255) * 8; const float4 b0 = *(const float4*)(cb + c8), b1 = *(const float4*)(cb + c8 + 4);
      bs[0] = b0.x; bs[1] = b0.y; bs[2] = b0.z; bs[3] = b0.w; bs[4] = b1.x; bs[5] = b1.y; bs[6] = b1.z; bs[7] = b1.w; }
    for (int i = gt; i < NLAT + NCTX; i += gs) {
        const bool isl = i < NLAT; const int ii = isl ? i : i - NLAT;
        const int c8 = (ii & 255) * 8, strip = ii >> 8;
        int tok0, ncol, c0, krows, r;
        if (isl) { const int cs = strip & 7, rr = (strip >> 3) & 63, bl = strip >> 9; tok0 = bl * SEQ + rr * 64; ncol = 64; c0 = cs * 8; krows = 3; r = rr; }
        else { const int cs = strip & 31, bl = strip >> 5; tok0 = TLAT + bl * CTX; ncol = 256; c0 = cs * 8; krows = 1; r = 0; }
        float acc[8][8];
#pragma unroll
        for (int o = 0; o < 8; ++o)
#pragma unroll
            for (int e = 0; e < 8; ++e) acc[o][e] = bs[e];
#pragma unroll
        for (int kh = 0; kh < 3; ++kh) {
            if (krows == 1 && kh != 1) continue;
            const int rr = r + kh - 1; if (isl && (rr < 0 || rr > 63)) continue;
            const bf16_t* rowp = XM + ((size_t)tok0 + (isl ? (kh - 1) * 64 : 0)) * E + c8;
            float4 wq[3][2];
#pragma unroll
            for (int kw = 0; kw < 3; ++kw) { const float* wp = cw + (size_t)(kh * 3 + kw) * E + c8; wq[kw][0] = *(const float4*)wp; wq[kw][1] = *(const float4*)(wp + 4); }
            uint4 xr[10];
#pragma unroll
            for (int cc = 0; cc < 10; ++cc) { int col = c0 - 1 + cc; col = col < 0 ? 0 : (col >= ncol ? ncol - 1 : col); xr[cc] = *(const uint4*)(rowp + (size_t)col * E); }
            if (c0 == 0) xr[0] = make_uint4(0u, 0u, 0u, 0u);
            if (c0 + 8 >= ncol) xr[9] = make_uint4(0u, 0u, 0u, 0u);
#pragma unroll
            for (int cc = 0; cc < 10; ++cc) {
                float x[8]; conv_unpack(xr[cc], x);
#pragma unroll
                for (int kw = 0; kw < 3; ++kw) { const int o = cc - kw; if (o < 0 || o > 7) continue;
#pragma unroll
                    for (int e = 0; e < 8; ++e) acc[o][e] += x[e] * ((e < 4) ? wq[kw][0] : wq[kw][1])[e & 3]; }
            }
        }
#pragma unroll
        for (int o = 0; o < 8; ++o)
            *(uint4*)(XCV + ((size_t)tok0 + c0 + o) * E + c8) = make_uint4(pack2(silu_f(acc[o][0]), silu_f(acc[o][1])), pack2(silu_f(acc[o][2]), silu_f(acc[o][3])), pack2(silu_f(acc[o][4]), silu_f(acc[o][5])), pack2(silu_f(acc[o][6]), silu_f(acc[o][7])));
    }
}

__device__ __forceinline__ void phase_gfold(const Params& p, int j, bf16_t* WgT, int bid, int nb) {
    const int tid = opq_tid(), lane = tid & 63, gw = bid * 8 + (tid >> 6), nw = nb * 8;
    const float* wif = p.m_w_if + (size_t)j * 2 * 3 * E * 8;
    for (int i = gw; i < 2 * E * 2; i += nw) {
        const int k = i >> 1, r = i & 1;
        float acc[8];
#pragma unroll
        for (int g = 0; g < 8; ++g) acc[g] = 0.f;
        if (k < E) {
            const int h = k >> 9;
            const float* wq = p.m_w_q + ((size_t)j * NH * DH + k) * DH; const float* wk = p.m_w_k + ((size_t)j * NH * DH + k) * DH;
            const float* gq = wif + (((size_t)r * 3 + 0) * E + h * DH) * 8; const float* gk = wif + (((size_t)r * 3 + 1) * E + h * DH) * 8;
#pragma unroll
            for (int t = 0; t < 8; ++t) { const int e = t * 64 + lane; const float a = wq[e], b = wk[e] * 0.044194173824159216f;
                const float4 q0 = *(const float4*)(gq + e * 8), q1 = *(const float4*)(gq + e * 8 + 4), k0 = *(const float4*)(gk + e * 8), k1 = *(const float4*)(gk + e * 8 + 4);
                acc[0] += a * q0.x + b * k0.x; acc[1] += a * q0.y + b * k0.y; acc[2] += a * q0.z + b * k0.z; acc[3] += a * q0.w + b * k0.w;
                acc[4] += a * q1.x + b * k1.x; acc[5] += a * q1.y + b * k1.y; acc[6] += a * q1.z + b * k1.z; acc[7] += a * q1.w + b * k1.w; }
#pragma unroll
            for (int g = 0; g < 8; ++g) acc[g] = wave_sum(acc[g]);
        } else {
            const float* gv = wif + (((size_t)r * 3 + 2) * E + (k - E)) * 8;
#pragma unroll
            for (int g = 0; g < 8; ++g) acc[g] = gv[g];
        }
        if (lane < 8) { float v = acc[0];
#pragma unroll
            for (int g = 1; g < 8; ++g) v = (lane == g) ? acc[g] : v;
            WgT[(size_t)(r * 8 + lane) * 4096 + k] = f2bf(v); }
    }
}
constexpr int GROW = 8208;
__device__ __forceinline__ void phase_gates(LAS unsigned char* lds, const bf16_t* XCV, const bf16_t* XM, const bf16_t* WgT, float* LI, float* LF, const float* b_i, const float* b_f) {
    const int tid = opq_tid(), lane = tid & 63, w = tid >> 6, fr = lane & 15, fq = lane >> 4, tsel = w & 3, khalf = w >> 2;
    __syncthreads();
    for (int i = tid; i < 16 * 512; i += NTHREADS) { const int c = i >> 9, k16 = i & 511; const uint4 v = *(const uint4*)(WgT + (size_t)c * 4096 + k16 * 8);
        *(LAS u32x4*)(lds + c * GROW + k16 * 16) = (u32x4){v.x, v.y, v.z, v.w}; }
    __syncthreads();
    LAS float* red = (LAS float*)(lds + 16 * GROW);
    const bf16_t* Asrc = khalf ? XM : XCV;
    for (int grp = blockIdx.x; grp < TH / 64; grp += gridDim.x) {
        const int tok0 = grp * 64 + tsel * 16;
        f32x4 acc = (f32x4){0.f, 0.f, 0.f, 0.f};
        const bf16_t* ap = Asrc + (size_t)(tok0 + fr) * E + fq * 8;
        LAS unsigned char* bp = lds + fr * GROW + (khalf * 2048 + fq * 8) * 2;
#pragma unroll 8
        for (int u = 0; u < 64; ++u) {
            const uint4 av = *(const uint4*)(ap + u * 32);
            union { bf16x8 v; unsigned wd[4]; } a_; a_.wd[0] = av.x; a_.wd[1] = av.y; a_.wd[2] = av.z; a_.wd[3] = av.w;
            const bf16x8 b = *(const LAS bf16x8*)(bp + u * 64);
            acc = __builtin_amdgcn_mfma_f32_16x16x32_bf16(a_.v, b, acc, 0, 0, 0);
        }
        if (khalf) *(LAS f32x4*)(red + (tsel * 64 + lane) * 4) = acc;
        __syncthreads();
        if (!khalf) {
            const f32x4 o = acc + *(const LAS f32x4*)(red + (tsel * 64 + lane) * 4);
            const int r = fr >> 3, g8 = fr & 7;
#pragma unroll
            for (int q = 0; q < 4; ++q) { const int tok = tok0 + 4 * fq + q;
                if (g8 < 4) LI[((size_t)r * TH + tok) * 4 + g8] = o[q] + b_i[r * 4 + g8];
                else { const int hh = g8 - 4; const float xx = o[q] + b_f[r * 4 + hh]; LF[((size_t)r * TH + tok) * 4 + hh] = fminf(xx, 0.f) - log1pf(__expf(-fabsf(xx))); } }
        }
        __syncthreads();
    }
}

__device__ __forceinline__ int scan_tok(int c, int jj, int dir, int bl) {
    if (c < 4) { int pos = 64 * c + jj; if (dir) pos = CTX - 1 - pos; return TLAT + bl * CTX + pos; }
    int pos = 64 * (c - 4) + jj; if (dir) pos = SEQ - 1 - pos; return bl * SEQ + pos;
}
#define SCAN_BAR() do { asm volatile("s_waitcnt lgkmcnt(0)" ::: "memory"); __builtin_amdgcn_s_barrier(); asm volatile("" ::: "memory"); } while (0)
__device__ __forceinline__ unsigned swap16(unsigned x) { return __builtin_amdgcn_alignbit(x, x, 16); }
__device__ __forceinline__ void phase_scan(LAS unsigned char* lds, const bf16_t* Q, const bf16_t* K, const bf16_t* V, const bf16_t* Sraw, const float* LI, const float* LF, bf16_t* Hf, bf16_t* Hr) {
    const int tid = opq_tid(), lane0 = tid & 63, w = __builtin_amdgcn_readfirstlane(tid >> 6), vg = w & 3, kh = w >> 2;
#define SCAN_OPQ int lane = lane0; asm volatile("" : "+v"(lane)); const int fr = lane & 15, fq = lane >> 4;
    LAS unsigned char* Qs = lds + L_QS; LAS unsigned char* Ks = lds + L_KS;
    LAS float* sArr = (LAS float*)(lds + L_SARR); LAS float* sDenB = (LAS float*)(lds + L_SDEN);
    LAS unsigned char* Vs = lds + L_VS; LAS unsigned char* xch = lds + L_XCH; LAS float* sDecay = sDenB + 576; LAS float* rowrec = (LAS float*)(lds + L_ROWREC);
    for (int unit = blockIdx.x; unit < 256; unit += gridDim.x) {
        const int xcd = unit & 7, ix = unit >> 3, stream = xcd * 4 + (ix >> 3), vs = ix & 7;
        const int dir = stream & 1, bl = (stream >> 1) & 3, h = stream >> 3;
        const int vcol0 = h * DH + vs * 64 + vg * 16, hq = h * DH;
        bf16_t* H = dir ? Hr : Hf;
        const bf16_t* Qh = Q + hq; const bf16_t* Kh = K + hq;
        const bf16_t* Sb = Sraw + (size_t)dir * HB * NH * 68 * 4096 + (size_t)(bl * NH + h) * 68 * 4096;
        f32x4 X[16];
#pragma unroll
        for (int t = 0; t < 16; ++t) X[t] = (f32x4){0.f, 0.f, 0.f, 0.f};
        f32x4 nX[4];
#pragma unroll
        for (int t = 0; t < 4; ++t) nX[t] = (f32x4){0.f, 0.f, 0.f, 0.f};
        float m_cur = 0.f, Pcur = 1.0f;
        u32x4 sf[2][2];
        __syncthreads();
        { SCAN_OPQ
#pragma unroll
          for (int i = 0; i < 8; ++i) { const int row = w * 8 + i; const size_t t = (size_t)scan_tok(0, row, dir, bl);
              __builtin_amdgcn_global_load_lds((const unsigned*)(Qh + t * E + lane * 8), (LAS unsigned*)(Qs + row * QROW), 16, 0, 0);
              __builtin_amdgcn_global_load_lds((const unsigned*)(Kh + t * E + lane * 8), (LAS unsigned*)(Ks + row * KROW), 16, 0, 0); }
          __builtin_amdgcn_global_load_lds((const unsigned*)(V + (size_t)scan_tok(0, w * 8 + (lane >> 3), dir, bl) * E + h * DH + vs * 64 + (lane & 7) * 8), (LAS unsigned*)(Vs + w * 1024), 16, 0, 0);
#pragma unroll
          for (int q = 0; q < 2; ++q)
#pragma unroll
              for (int st = 0; st < 2; ++st) { const uint4 v_ = *(const uint4*)(Sb + (size_t)(16 * (2 * kh + q) + fr) * 64 + 32 * st + 8 * fq); sf[q][st] = (u32x4){v_.x, v_.y, v_.z, v_.w}; }
        }
        const int stp = dir ? -1 : 1;
#define SCAN_TOK0(cc) (((cc) < 4) ? (TLAT + bl * CTX + (dir ? CTX - 1 - 64 * (cc) : 64 * (cc))) : (bl * SEQ + (dir ? SEQ - 1 - 64 * ((cc) - 4) : 64 * ((cc) - 4))))
        float li_n = 0.f, lf_n = 0.f;
        if (w == 7) { const size_t t = (size_t)scan_tok(0, lane0, dir, bl); li_n = LI[((size_t)dir * TH + t) * 4 + h]; lf_n = LF[((size_t)dir * TH + t) * 4 + h]; }
        for (int c = 0; c < 68; ++c) {
            const int pb = c & 1;
            LAS float* sWp = sArr + pb * 320; LAS float* sWs = sWp + 64; LAS float* sEmn = sWp + 128; LAS float* sEm = sWp + 192;
            if (c == 0) {
                if (w == 7) { SCAN_OPQ
                    const float bc = wave_scan_sum(lf_n); const float g = li_n - bc; const float rm = wave_scan_max(g);
                    const float Mj = fmaxf(m_cur, rm); const float M63 = __shfl(Mj, 63), b63 = __shfl(bc, 63);
                    const float dec = fmaxf(__expf(m_cur - M63), 1.0e-9f); float rn = 1.0f; if (Pcur < 1.0e-9f) { rn = Pcur; Pcur = 1.0f; }
                    const float Pn = Pcur * dec, iPn = 1.0f / Pn;
                    sWp[lane] = __expf(m_cur - Mj) * Pcur; sWs[lane] = __expf(g - M63) * iPn; sEmn[lane] = __expf(-(bc + Mj)); sEm[lane] = __expf(M63 - Mj) * Pn;
                    if (lane == 0) sDecay[pb] = rn;
                    m_cur = b63 + M63; Pcur = Pn;
                }
                asm volatile("s_waitcnt vmcnt(0)" ::: "memory");
                SCAN_BAR();
            }
            const bool more = (c + 1 < 68);
            bf16x8 vf[2]; u32x4 sfn[2][2];
            { SCAN_OPQ
#pragma unroll
              for (int st = 0; st < 2; ++st) { union { bf16x8 v; s16x4 h4[2]; } u_;
#pragma unroll
                  for (int hh = 0; hh < 2; ++hh) u_.h4[hh] = __builtin_amdgcn_ds_read_tr16_b64_v4i16((LAS s16x4*)(Vs + (32 * st + 8 * fq + 4 * hh + (fr >> 2)) * 128 + (vg * 16 + 4 * (fr & 3)) * 2));
                  vf[st] = u_.v; }
              if (more && w == 7) { const size_t t = (size_t)(SCAN_TOK0(c + 1) + stp * lane); li_n = LI[((size_t)dir * TH + t) * 4 + h]; lf_n = LF[((size_t)dir * TH + t) * 4 + h]; }
              if (more) {
#pragma unroll
                  for (int q = 0; q < 2; ++q)
#pragma unroll
                      for (int st = 0; st < 2; ++st) { const uint4 v_ = *(const uint4*)(Sb + ((size_t)(c + 1) * 64 + 16 * (2 * kh + q) + fr) * 64 + 32 * st + 8 * fq); sfn[q][st] = (u32x4){v_.x, v_.y, v_.z, v_.w}; }
              } else {
#pragma unroll
                  for (int q = 0; q < 2; ++q)
#pragma unroll
                      for (int st = 0; st < 2; ++st) sfn[q][st] = sf[q][st];
              }
            }
            { const float rn = sDecay[pb];
              if (rn != 1.0f) {
#pragma unroll
                  for (int t = 0; t < 16; ++t) X[t] = X[t] * rn;
#pragma unroll
                  for (int t = 0; t < 4; ++t) nX[t] = nX[t] * rn; } }
            f32x4 o[4];
            { SCAN_OPQ
            f32x4 qn[4];
#pragma unroll
            for (int jj = 0; jj < 4; ++jj) { o[jj] = (f32x4){0.f, 0.f, 0.f, 0.f}; qn[jj] = (f32x4){0.f, 0.f, 0.f, 0.f}; }
            bf16x8 af[2][4];
            { const int kb0 = kh * 256 + 32 * ((0 + 2 * vg) & 7);
#pragma unroll
              for (int jj = 0; jj < 4; ++jj) af[0][jj] = *(const LAS bf16x8*)(Qs + ((((jj + 2 * kh) & 3) * 16 + fr) * QROW) + (kb0 + 8 * fq) * 2); }
#pragma unroll
            for (int u = 0; u < 8; ++u) {
                if (u + 1 < 8) { const int kb1 = kh * 256 + 32 * ((u + 1 + 2 * vg) & 7);
#pragma unroll
                    for (int jj = 0; jj < 4; ++jj) af[(u + 1) & 1][jj] = *(const LAS bf16x8*)(Qs + ((((jj + 2 * kh) & 3) * 16 + fr) * QROW) + (kb1 + 8 * fq) * 2); }
                union { bf16x8 v; unsigned wd[4]; } bfr;
                bfr.wd[0] = pack2(X[2 * u][0], X[2 * u][1]); bfr.wd[1] = pack2(X[2 * u][2], X[2 * u][3]);
                bfr.wd[2] = pack2(X[2 * u + 1][0], X[2 * u + 1][1]); bfr.wd[3] = pack2(X[2 * u + 1][2], X[2 * u + 1][3]);
                union { bf16x8 v; unsigned wd[4]; } nfr;
                if (u < 2) { nfr.wd[0] = pack2(nX[2 * u][0], nX[2 * u][1]); nfr.wd[1] = pack2(nX[2 * u][2], nX[2 * u][3]);
                    nfr.wd[2] = pack2(nX[2 * u + 1][0], nX[2 * u + 1][1]); nfr.wd[3] = pack2(nX[2 * u + 1][2], nX[2 * u + 1][3]); }
                __builtin_amdgcn_sched_barrier(0);
#pragma unroll
                for (int jj = 0; jj < 4; ++jj) {
                    o[jj] = __builtin_amdgcn_mfma_f32_16x16x32_bf16(af[u & 1][jj], bfr.v, o[jj], 0, 0, 0);
                    if (u < 2) qn[jj] = __builtin_amdgcn_mfma_f32_16x16x32_bf16(af[u & 1][jj], nfr.v, qn[jj], 0, 0, 0);
                }
                __builtin_amdgcn_sched_barrier(0);
            }
            if (fr == 0) {
#pragma unroll
                for (int jj = 0; jj < 4; ++jj)
#pragma unroll
                    for (int r = 0; r < 4; ++r) sDenB[w * 64 + ((jj + 2 * kh) & 3) * 16 + 4 * fq + r] = qn[jj][r];
            }
            }
            SCAN_BAR();
            if (more) { SCAN_OPQ
                const int tb = SCAN_TOK0(c + 1);
                const bf16_t* qrow = Qh + (ptrdiff_t)(tb + stp * (w * 8)) * E + lane * 8; const ptrdiff_t rstep = (ptrdiff_t)stp * E;
#pragma unroll
                for (int i = 0; i < 8; ++i) __builtin_amdgcn_global_load_lds((const unsigned*)(qrow + i * rstep), (LAS unsigned*)(Qs + (w * 8 + i) * QROW), 16, 0, 0);
            }
            bf16x8 wv[2], wsf[2];
            { SCAN_OPQ
#pragma unroll
                for (int st = 0; st < 2; ++st) { const f32x4 a0 = *(const LAS f32x4*)(sWs + 32 * st + 8 * fq), a1 = *(const LAS f32x4*)(sWs + 32 * st + 8 * fq + 4);
                    union { bf16x8 v; unsigned wd[4]; } t_; t_.wd[0] = pack2(a0[0], a0[1]); t_.wd[1] = pack2(a0[2], a0[3]); t_.wd[2] = pack2(a1[0], a1[1]); t_.wd[3] = pack2(a1[2], a1[3]); wsf[st] = t_.v;
                    union { bf16x8 v; unsigned wd[4]; } vv, ww; vv.v = vf[st];
                    ww.wd[0] = pack2(__uint_as_float(vv.wd[0] << 16) * a0[0], __uint_as_float(vv.wd[0] & 0xffff0000u) * a0[1]); ww.wd[1] = pack2(__uint_as_float(vv.wd[1] << 16) * a0[2], __uint_as_float(vv.wd[1] & 0xffff0000u) * a0[3]);
                    ww.wd[2] = pack2(__uint_as_float(vv.wd[2] << 16) * a1[0], __uint_as_float(vv.wd[2] & 0xffff0000u) * a1[1]); ww.wd[3] = pack2(__uint_as_float(vv.wd[3] << 16) * a1[2], __uint_as_float(vv.wd[3] & 0xffff0000u) * a1[3]);
                    wv[st] = ww.v; }
                bf16x8 kf[2][2][2];
#define SCAN_KT(dst, T_) do { const int kc_ = kh * 256 + 32 * ((((T_) >> 1) + 2 * vg) & 7) + 8 * (fr & 3) + 4 * ((T_) & 1); \
        _Pragma("unroll") for (int st = 0; st < 2; ++st) { union { bf16x8 v; s16x4 h4[2]; } a_; \
            _Pragma("unroll") for (int hh = 0; hh < 2; ++hh) a_.h4[hh] = __builtin_amdgcn_ds_read_tr16_b64_v4i16((LAS s16x4*)(Ks + (32 * st + 8 * fq + 4 * hh + (fr >> 2)) * KROW + kc_ * 2)); \
            dst[st] = a_.v; } } while (0)
                SCAN_KT(kf[0][0], 0); SCAN_KT(kf[0][1], 1);
#pragma unroll
                for (int P = 0; P < 8; ++P) {
                    if (P + 1 < 8) { SCAN_KT(kf[(P + 1) & 1][0], 2 * P + 2); SCAN_KT(kf[(P + 1) & 1][1], 2 * P + 3); }
                    __builtin_amdgcn_sched_barrier(0);
#pragma unroll
                    for (int tp = 0; tp < 2; ++tp)
#pragma unroll
                        for (int st = 0; st < 2; ++st) { const int T = 2 * P + tp;
                            X[T] = __builtin_amdgcn_mfma_f32_16x16x32_bf16(kf[P & 1][tp][st], wv[st], X[T], 0, 0, 0);
                            if (T < 4) nX[T & 3] = __builtin_amdgcn_mfma_f32_16x16x32_bf16(kf[P & 1][tp][st], wsf[st], nX[T & 3], 0, 0, 0); }
                    __builtin_amdgcn_sched_barrier(0);
                }
#undef SCAN_KT
            }
            SCAN_BAR();
            if (more) {
                { SCAN_OPQ
                  const int tb = SCAN_TOK0(c + 1);
                  const bf16_t* krow = Kh + (ptrdiff_t)(tb + stp * (w * 8)) * E + lane * 8;
                  const ptrdiff_t rstep = (ptrdiff_t)stp * E;
#pragma unroll
                  for (int i = 0; i < 8; ++i) __builtin_amdgcn_global_load_lds((const unsigned*)(krow + i * rstep), (LAS unsigned*)(Ks + (w * 8 + i) * KROW), 16, 0, 0);
                  __builtin_amdgcn_global_load_lds((const unsigned*)(V + (ptrdiff_t)(tb + stp * (w * 8 + (lane >> 3))) * E + h * DH + vs * 64 + (lane & 7) * 8), (LAS unsigned*)(Vs + w * 1024), 16, 0, 0);
                }
            }
            if (more && w == 7) { SCAN_OPQ
                LAS float* nG = sArr + (pb ^ 1) * 320;
                const float bc = wave_scan_sum(lf_n); const float g = li_n - bc; const float rm = wave_scan_max(g);
                const float Mj = fmaxf(m_cur, rm); const float M63 = __shfl(Mj, 63), b63 = __shfl(bc, 63);
                const float dec = fmaxf(__expf(m_cur - M63), 1.0e-9f); float rn = 1.0f; if (Pcur < 1.0e-9f) { rn = Pcur; Pcur = 1.0f; }
                const float Pn = Pcur * dec, iPn = 1.0f / Pn;
                nG[lane] = __expf(m_cur - Mj) * Pcur; nG[64 + lane] = __expf(g - M63) * iPn; nG[128 + lane] = __expf(-(bc + Mj)); nG[192 + lane] = __expf(M63 - Mj) * Pn;
                if (lane == 0) sDecay[pb ^ 1] = rn;
                m_cur = b63 + M63; Pcur = Pn;
            }
            if (tid < 64) { float sq = 0.f;
#pragma unroll
                for (int ww = 0; ww < 8; ++ww) sq += sDenB[ww * 64 + tid];
                const float wp_ = sWp[tid];
                *(LAS f32x4*)(rowrec + tid * 4) = (f32x4){wp_, sEm[tid], sEmn[tid], wp_ * sq}; }
            { SCAN_OPQ
#pragma unroll
                for (int q = 0; q < 2; ++q) { const f32x4 ov = o[2 + q];
                    *(LAS u32x2*)(xch + w * 1024 + ((q * 4 + fq) * 16 + fr) * 8) = (u32x2){pack2(ov[0], ov[1]), pack2(ov[2], ov[3])}; }
            }
            SCAN_BAR();
            { SCAN_OPQ
                const int partner = vg + 4 * (1 - kh); const int vcol = vcol0 + fr;
                bf16_t* hrow = H + (ptrdiff_t)(SCAN_TOK0(c) + stp * (2 * kh * 16 + 4 * fq)) * E + vcol; const ptrdiff_t hstep = (ptrdiff_t)stp * E;
                u32x2 pw[2]; f32x4 rec[2][4];
#pragma unroll
                for (int q = 0; q < 2; ++q) { pw[q] = *(const LAS u32x2*)(xch + partner * 1024 + ((q * 4 + fq) * 16 + fr) * 8);
#pragma unroll
                    for (int r = 0; r < 4; ++r) rec[q][r] = *(const LAS f32x4*)(rowrec + ((2 * kh + q) * 16 + 4 * fq + r) * 4); }
                __builtin_amdgcn_sched_barrier(0);
                f32x4 pvv[2], dsum[2];
#pragma unroll
                for (int q = 0; q < 2; ++q) { pvv[q] = (f32x4){0.f, 0.f, 0.f, 0.f}; dsum[q] = (f32x4){0.f, 0.f, 0.f, 0.f};
#pragma unroll
                    for (int st = 0; st < 2; ++st) { union { bf16x8 v; u32x4 w4; } a_; a_.w4 = sf[q][st];
                        pvv[q] = __builtin_amdgcn_mfma_f32_16x16x32_bf16(a_.v, wv[st], pvv[q], 0, 0, 0);
                        dsum[q] = __builtin_amdgcn_mfma_f32_16x16x32_bf16(a_.v, wsf[st], dsum[q], 0, 0, 0); } }
#pragma unroll
                for (int q = 0; q < 2; ++q) {
                    const int jt = 2 * kh + q;
                    const float pv_[4] = {__uint_as_float(pw[q].x << 16), __uint_as_float(pw[q].x & 0xffff0000u), __uint_as_float(pw[q].y << 16), __uint_as_float(pw[q].y & 0xffff0000u)};
#pragma unroll
                    for (int r = 0; r < 4; ++r) { const int j = jt * 16 + 4 * fq + r; const f32x4 rc = rec[q][r];
                        const float num = (o[q][r] + pv_[r]) * rc[0] + rc[1] * pvv[q][r], den = rc[3] + rc[1] * dsum[q][r];
                        const float dn = fmaxf(fabsf(den), rc[2]);
                        hrow[(q * 16 + r) * hstep] = f2bf(num * __builtin_amdgcn_rcpf(dn)); }
                }
            }
#pragma unroll
            for (int q = 0; q < 2; ++q)
#pragma unroll
                for (int st = 0; st < 2; ++st) sf[q][st] = sfn[q][st];
            asm volatile("s_waitcnt vmcnt(8)" ::: "memory");
            SCAN_BAR();
        }
    }
    __syncthreads();
}
#undef SCAN_TOK0
#undef SCAN_OPQ
#undef SCAN_BAR

constexpr int YZW = 4096;
__device__ __forceinline__ int fplane_off(int n2, int n1) { return n2 * 128 + ((((n1 >> 3) ^ (n2 & 7))) << 4) + (n1 & 7) * 2; }
__device__ __forceinline__ void phase_fft(LAS unsigned char* lds, const bf16_t* YZ, bf16_t* Yout, int nbat) {
    const int tid0 = opq_tid(), w = tid0 >> 6, pt = w & 3, chalf = w >> 2;
#define FFT_OPQ int tid = tid0; asm volatile("" : "+v"(tid)); const int lane = tid & 63, fr = lane & 15, fq = lane >> 4;
    const int lane = tid0 & 63, fr = lane & 15, fq = lane >> 4;
    bf16x8 Cm[2], Sm[2], nSm[2];
#pragma unroll
    for (int ks = 0; ks < 2; ++ks)
#pragma unroll
        for (int jj = 0; jj < 8; ++jj) { const int n1 = 32 * ks + 8 * fq + jj, p1 = 16 * pt + fr; const float a = (float)((n1 * p1) & 63) * (2.0f / 64.0f);
            const float cv = cospif(a) * 0.125f, sv = sinpif(a) * 0.125f; Cm[ks][jj] = (short)f2bf(cv); Sm[ks][jj] = (short)f2bf(sv); nSm[ks][jj] = (short)f2bf(-sv); }
    float twc[4][4], tws[4][4];
#pragma unroll
    for (int nt = 0; nt < 4; ++nt)
#pragma unroll
        for (int r = 0; r < 4; ++r) { const int n2 = 16 * nt + 4 * fq + r, p1 = 16 * pt + fr; const float a = (float)(n2 * p1) * (2.0f / 4096.0f); twc[nt][r] = cospif(a); tws[nt][r] = sinpif(a); }
    LAS unsigned char* G2 = lds + 131072;
    __syncthreads();
#pragma unroll
    for (int q = 0; q < 2; ++q) { const int idx = 2 * w + q, p2t = idx >> 2, ks = (idx >> 1) & 1, sn = idx & 1; bf16x8 g;
#pragma unroll
        for (int jj = 0; jj < 8; ++jj) { const int n2 = 32 * ks + ((jj < 4) ? (4 * fq + jj) : (16 + 4 * fq + jj - 4)), p2 = 16 * p2t + fr; const float a = (float)((n2 * p2) & 63) * (2.0f / 64.0f);
            g[jj] = (short)f2bf((sn ? sinpif(a) : cospif(a)) * 0.125f); }
        *(LAS bf16x8*)(G2 + idx * 1024 + lane * 16) = g; }
    for (int slab = blockIdx.x; slab < nbat * 128; slab += gridDim.x) {
        const int bl = slab >> 7, id = slab & 127, sl = (id & 7) * 16 + (id >> 3);
        const bool special = (sl & 15) == 0;
        const bf16_t* src = YZ + (size_t)bl * SEQ * YZW + sl * 16;
        __syncthreads();
        { FFT_OPQ
            uint4 vr[8], vi[8];
#pragma unroll
            for (int it = 0; it < 8; ++it) { const int n1 = (it << 3) | (lane >> 3), n2 = (w << 3) | (lane & 7);
                const bf16_t* gp = src + (size_t)(64 * n1 + n2) * YZW; vr[it] = *(const uint4*)gp; vi[it] = *(const uint4*)(gp + 8); }
#pragma unroll
            for (int it = 0; it < 8; ++it) { const int n1 = (it << 3) | (lane >> 3), n2 = (w << 3) | (lane & 7);
                LAS unsigned char* d = lds + fplane_off(n2, n1);
                const unsigned wr_[4] = {vr[it].x, vr[it].y, vr[it].z, vr[it].w}, wi_[4] = {vi[it].x, vi[it].y, vi[it].z, vi[it].w};
#pragma unroll
                for (int c = 0; c < 8; ++c) { *(LAS bf16_t*)(d + c * 8192) = (bf16_t)((c & 1) ? (wr_[c >> 1] >> 16) : (wr_[c >> 1] & 0xffffu));
                    *(LAS bf16_t*)(d + (8 + c) * 8192) = (bf16_t)((c & 1) ? (wi_[c >> 1] >> 16) : (wi_[c >> 1] & 0xffffu)); } }
            asm volatile("" ::: "memory");
        }
        __syncthreads();
        uint4 zv[8][2];
        { const int tidz = tid0;
#pragma unroll
          for (int i = 0; i < 8; ++i) { const bf16_t* zp = YZ + ((size_t)bl * SEQ + tidz + NTHREADS * i) * YZW + 2048 + sl * 16; zv[i][0] = *(const uint4*)zp; zv[i][1] = *(const uint4*)(zp + 8); } }
        for (int ci = 0; ci < 4; ++ci) { FFT_OPQ
            const int c = 4 * chalf + ci;
            const bool want_im = special && (c == 0);
            LAS unsigned char* Pr = lds + c * 8192; LAS unsigned char* Pi = lds + (8 + c) * 8192;
            f32x4 Xr[4], Xi[4];
#pragma unroll
            for (int nt = 0; nt < 4; ++nt) {
                f32x4 xr = (f32x4){0.f, 0.f, 0.f, 0.f}, xi = (f32x4){0.f, 0.f, 0.f, 0.f};
                const int n2 = 16 * nt + fr;
#pragma unroll
                for (int ks = 0; ks < 2; ++ks) { const int off = n2 * 128 + (((4 * ks + fq) ^ (n2 & 7)) << 4);
                    const bf16x8 yr = *(const LAS bf16x8*)(Pr + off), yi = *(const LAS bf16x8*)(Pi + off);
                    xr = __builtin_amdgcn_mfma_f32_16x16x32_bf16(yr, Cm[ks], xr, 0, 0, 0); xr = __builtin_amdgcn_mfma_f32_16x16x32_bf16(yi, Sm[ks], xr, 0, 0, 0);
                    xi = __builtin_amdgcn_mfma_f32_16x16x32_bf16(yi, Cm[ks], xi, 0, 0, 0); xi = __builtin_amdgcn_mfma_f32_16x16x32_bf16(yr, nSm[ks], xi, 0, 0, 0); }
#pragma unroll
                for (int r = 0; r < 4; ++r) { Xr[nt][r] = xr[r] * twc[nt][r] + xi[r] * tws[nt][r]; Xi[nt][r] = xi[r] * twc[nt][r] - xr[r] * tws[nt][r]; }
            }
            union { bf16x8 v; unsigned wd[4]; } Br[2], Bi[2], nBr[2];
#pragma unroll
            for (int ks = 0; ks < 2; ++ks) {
                Br[ks].wd[0] = pack2(Xr[2 * ks][0], Xr[2 * ks][1]); Br[ks].wd[1] = pack2(Xr[2 * ks][2], Xr[2 * ks][3]); Br[ks].wd[2] = pack2(Xr[2 * ks + 1][0], Xr[2 * ks + 1][1]); Br[ks].wd[3] = pack2(Xr[2 * ks + 1][2], Xr[2 * ks + 1][3]);
                Bi[ks].wd[0] = pack2(Xi[2 * ks][0], Xi[2 * ks][1]); Bi[ks].wd[1] = pack2(Xi[2 * ks][2], Xi[2 * ks][3]); Bi[ks].wd[2] = pack2(Xi[2 * ks + 1][0], Xi[2 * ks + 1][1]); Bi[ks].wd[3] = pack2(Xi[2 * ks + 1][2], Xi[2 * ks + 1][3]);
#pragma unroll
                for (int q = 0; q < 4; ++q) nBr[ks].wd[q] = Br[ks].wd[q] ^ 0x80008000u; }
            f32x4 o[4], oi[4];
#pragma unroll
            for (int p2t = 0; p2t < 4; ++p2t) { f32x4 a = (f32x4){0.f, 0.f, 0.f, 0.f}, ai = (f32x4){0.f, 0.f, 0.f, 0.f};
#pragma unroll
                for (int ks = 0; ks < 2; ++ks) { const bf16x8 cg = *(const LAS bf16x8*)(G2 + ((p2t * 2 + ks) * 2) * 1024 + lane * 16), sg = *(const LAS bf16x8*)(G2 + ((p2t * 2 + ks) * 2 + 1) * 1024 + lane * 16);
                    a = __builtin_amdgcn_mfma_f32_16x16x32_bf16(cg, Br[ks].v, a, 0, 0, 0); a = __builtin_amdgcn_mfma_f32_16x16x32_bf16(sg, Bi[ks].v, a, 0, 0, 0);
                    if (want_im) { ai = __builtin_amdgcn_mfma_f32_16x16x32_bf16(cg, Bi[ks].v, ai, 0, 0, 0); ai = __builtin_amdgcn_mfma_f32_16x16x32_bf16(sg, nBr[ks].v, ai, 0, 0, 0); } }
                o[p2t] = a; oi[p2t] = ai; }
            __syncthreads();
#pragma unroll
            for (int p2t = 0; p2t < 4; ++p2t)
#pragma unroll
                for (int r = 0; r < 4; ++r) { const int po = ((16 * p2t + 4 * fq + r) * 64 + 16 * pt + fr) * 2; *(LAS bf16_t*)(Pr + po) = f2bf(o[p2t][r]); if (want_im) *(LAS bf16_t*)(Pi + po) = f2bf(oi[p2t][r]); }
        }
        __syncthreads();
#pragma unroll
        for (int hb = 0; hb < 2; ++hb) { FFT_OPQ
#pragma unroll
          for (int i = 0; i < 4; ++i) { const int pp = tid + NTHREADS * (hb * 4 + i), pm = (SEQ - pp) & (SEQ - 1); const size_t tok = (size_t)bl * SEQ + pp;
            const unsigned z0[4] = {zv[hb * 4 + i][0].x, zv[hb * 4 + i][0].y, zv[hb * 4 + i][0].z, zv[hb * 4 + i][0].w}, z1[4] = {zv[hb * 4 + i][1].x, zv[hb * 4 + i][1].y, zv[hb * 4 + i][1].z, zv[hb * 4 + i][1].w};
            float yd[8], ym[8];
#pragma unroll
            for (int c = 0; c < 8; ++c) { yd[c] = bf2f(*(const LAS bf16_t*)(lds + c * 8192 + pp * 2)); ym[c] = bf2f(*(const LAS bf16_t*)(lds + c * 8192 + pm * 2)); }
            if (special) { const float gi0 = bf2f(*(const LAS bf16_t*)(lds + 8 * 8192 + pp * 2)), gi1 = bf2f(*(const LAS bf16_t*)(lds + 8 * 8192 + pm * 2));
                const float a0 = 0.5f * (yd[0] + ym[0]); yd[0] = a0; ym[0] = 0.5f * (gi0 + gi1); }
#pragma unroll
            for (int c = 0; c < 8; ++c) { yd[c] *= silu_f(bfw(z0, c)); ym[c] *= silu_f(bfw(z1, c)); }
            *(uint4*)(Yout + tok * E + sl * 16) = make_uint4(pack2(yd[0], yd[1]), pack2(yd[2], yd[3]), pack2(yd[4], yd[5]), pack2(yd[6], yd[7]));
            *(uint4*)(Yout + tok * E + sl * 16 + 8) = make_uint4(pack2(ym[0], ym[1]), pack2(ym[2], ym[3]), pack2(ym[4], ym[5]), pack2(ym[6], ym[7])); }
          asm volatile("" ::: "memory"); }
    }
    __syncthreads();
}
#undef FFT_OPQ
__device__ __forceinline__ void phase_ctxdft(LAS unsigned char* lds, const bf16_t* YZ, bf16_t* Yout, int nbat, int tlat, const bf16_t* Tc) {
    const int tid = opq_tid(), lane = tid & 63, w = tid >> 6, fr = lane & 15, fq = lane >> 4;
    LAS unsigned char* Yt = lds;
    LAS float* Ot = (LAS float*)(lds + 16 * 528);
    for (int slab = blockIdx.x; slab < nbat * 128; slab += gridDim.x) {
        const int bl = slab >> 7, id = slab & 127, sl = (id & 7) * 16 + (id >> 3);
        const bool special = (sl & 15) == 0;
        __syncthreads();
        if (tid < 256) { const bf16_t* gp = YZ + ((size_t)tlat + bl * CTX + tid) * YZW + sl * 16; const uint4 a = *(const uint4*)gp, b = *(const uint4*)(gp + 8);
            const unsigned aw[4] = {a.x, a.y, a.z, a.w}, bw[4] = {b.x, b.y, b.z, b.w};
#pragma unroll
            for (int c = 0; c < 8; ++c) { *(LAS bf16_t*)(Yt + c * 528 + tid * 2) = (bf16_t)((c & 1) ? (aw[c >> 1] >> 16) : (aw[c >> 1] & 0xffffu));
                *(LAS bf16_t*)(Yt + (8 + c) * 528 + tid * 2) = (bf16_t)((c & 1) ? (bw[c >> 1] >> 16) : (bw[c >> 1] & 0xffffu)); } }
        __syncthreads();
#pragma unroll
        for (int q = 0; q < 2; ++q) { const int pt = 2 * w + q;
            f32x4 ac = (f32x4){0.f, 0.f, 0.f, 0.f}, as = (f32x4){0.f, 0.f, 0.f, 0.f};
            { const bf16_t* T = Tc;
                bf16x8 a1[8], a2[8];
#pragma unroll
                for (int ks = 0; ks < 8; ++ks) { const bf16_t* tp = T + (size_t)(16 * pt + fr) * 256 + 32 * ks + 8 * fq; const uint4 u1 = *(const uint4*)tp, u2 = *(const uint4*)(tp + 65536);
                    union { bf16x8 v; unsigned wd[4]; } t1, t2; t1.wd[0] = u1.x; t1.wd[1] = u1.y; t1.wd[2] = u1.z; t1.wd[3] = u1.w; t2.wd[0] = u2.x; t2.wd[1] = u2.y; t2.wd[2] = u2.z; t2.wd[3] = u2.w; a1[ks] = t1.v; a2[ks] = t2.v; }
#pragma unroll
                for (int ks = 0; ks < 8; ++ks) { const bf16x8 bb = *(const LAS bf16x8*)(Yt + fr * 528 + (32 * ks + 8 * fq) * 2);
                    ac = __builtin_amdgcn_mfma_f32_16x16x32_bf16(a1[ks], bb, ac, 0, 0, 0); as = __builtin_amdgcn_mfma_f32_16x16x32_bf16(a2[ks], bb, as, 0, 0, 0); }
            }
#pragma unroll
            for (int r = 0; r < 4; ++r) { const float s_im = __shfl_down(as[r], 8), c_im = __shfl_down(ac[r], 8);
                float dv = ac[r] + s_im, mv = ac[r] - s_im;
                if (special && fr == 0) { dv = ac[r]; mv = c_im; }
                if (fr < 8) { const int pp = 16 * pt + 4 * fq + r; Ot[pp * 16 + fr] = dv; Ot[pp * 16 + 8 + fr] = mv; } }
        }
        __syncthreads();
        { const int pp = tid >> 1, hsel = tid & 1; const size_t tok = (size_t)tlat + bl * CTX + pp;
          const f32x4 o0 = *(const LAS f32x4*)(Ot + pp * 16 + hsel * 8), o1 = *(const LAS f32x4*)(Ot + pp * 16 + hsel * 8 + 4); const float ow[8] = {o0[0], o0[1], o0[2], o0[3], o1[0], o1[1], o1[2], o1[3]};
          const uint4 zv = *(const uint4*)(YZ + tok * YZW + 2048 + sl * 16 + hsel * 8); const unsigned zw[4] = {zv.x, zv.y, zv.z, zv.w};
          float y[8];
#pragma unroll
          for (int c = 0; c < 8; ++c) y[c] = ow[c] * silu_f(bfw(zw, c));
          *(uint4*)(Yout + tok * E + sl * 16 + hsel * 8) = make_uint4(pack2(y[0], y[1]), pack2(y[2], y[3]), pack2(y[4], y[5]), pack2(y[6], y[7])); }
    }
    __syncthreads();
}

__device__ __forceinline__ void phase_hstats(int nrows, const bf16_t* Hf, const bf16_t* Hr, float* stats) {
    const int tid = opq_tid(), lane = tid & 63, gw = blockIdx.x * 8 + (tid >> 6), nw = gridDim.x * 8;
    for (int t = gw; t < nrows; t += nw) {
        float mu4[NH], rs4[NH];
#pragma unroll
        for (int hh = 0; hh < NH; ++hh) {
            const size_t off = (size_t)t * E + hh * DH + lane * 8;
            const uint4 a = *(const uint4*)(Hf + off), b = *(const uint4*)(Hr + off);
            float hs[8]; const unsigned aw[4] = {a.x, a.y, a.z, a.w}, bw[4] = {b.x, b.y, b.z, b.w};
#pragma unroll
            for (int i = 0; i < 8; ++i) hs[i] = bfw(aw, i) + bfw(bw, i);
            float s = 0.f;
#pragma unroll
            for (int i = 0; i < 8; ++i) s += hs[i];
            const float mu = wave_sum(s) * (1.0f / DH);
            float q = 0.f;
#pragma unroll
            for (int i = 0; i < 8; ++i) { const float d = hs[i] - mu; q += d * d; }
            mu4[hh] = mu; rs4[hh] = rsqrtf(wave_sum(q) * (1.0f / DH) + EPS);
        }
        if (lane == 0) { *(float4*)(stats + (size_t)t * 8) = make_float4(mu4[0], rs4[0], mu4[1], rs4[1]); *(float4*)(stats + (size_t)t * 8 + 4) = make_float4(mu4[2], rs4[2], mu4[3], rs4[3]); }
    }
}
__device__ __forceinline__ void phase_final(const Params& p) {
    const int tid = opq_tid(), lane = tid & 63, gw = blockIdx.x * 8 + (tid >> 6), nw = gridDim.x * 8;
    for (int r = gw; r < NBATCH * SEQ; r += nw) {
        float* dst = p.out + (size_t)r * D; const bf16_t* src = (const bf16_t*)dst; float v[2][8]; float ss = 0.f;
#pragma unroll
        for (int i = 0; i < 2; ++i) { const uint4 a = *(const uint4*)(src + i * 512 + lane * 8); conv_unpack(a, v[i]); }
#pragma unroll
        for (int i = 0; i < 2; ++i)
#pragma unroll
            for (int e = 0; e < 8; ++e) ss += v[i][e] * v[i][e];
        ss = wave_sum(ss); const float rs = rsqrtf(ss * (1.0f / D) + EPS);
        asm volatile("s_waitcnt vmcnt(0)" ::: "memory");
#pragma unroll
        for (int i = 0; i < 2; ++i) { const int c0 = i * 512 + lane * 8;
            const float4 g0 = *(const float4*)(p.norm_f + c0), g1 = *(const float4*)(p.norm_f + c0 + 4);
            *(float4*)(dst + c0) = make_float4(v[i][0] * rs * g0.x, v[i][1] * rs * g0.y, v[i][2] * rs * g0.z, v[i][3] * rs * g0.w);
            *(float4*)(dst + c0 + 4) = make_float4(v[i][4] * rs * g1.x, v[i][5] * rs * g1.y, v[i][6] * rs * g1.z, v[i][7] * rs * g1.w); }
    }
}

__device__ __forceinline__ Params launder_params(Params q) {
    size_t z = 0; asm volatile("" : "+s"(z));
    q.x += z; q.c += z; q.ctx += z; q.c_ctx += z; q.norm_g += z; q.w_ada += z; q.b_ada += z; q.m_w_in += z; q.m_conv_w += z; q.m_conv_b += z; q.m_w_q += z; q.m_w_k += z; q.m_w_if += z;
    q.m_b_i += z; q.m_b_f += z; q.m_ln_w += z; q.m_skip += z; q.m_w_out += z; q.f_w_in += z; q.f_w_out += z; q.norm_f += z; q.out += z; q.ws += z;
    return q;
}
#define PH_BEGIN if (ph >= p0.ph_lo && ph < p0.ph_hi) { const Params p = launder_params(p0); unsigned char* ws = p.ws; int G = G0, cid = cid0; asm volatile("" : "+s"(G), "+s"(cid)); (void)G; (void)cid; \
        bf16_t* HMOD = (bf16_t*)(ws + WS_HMOD); bf16_t* B0 = (bf16_t*)(ws + WS_B0); bf16_t* B1 = (bf16_t*)(ws + WS_B0 + BUFSZ); bf16_t* B2 = (bf16_t*)(ws + WS_B0 + 2 * BUFSZ); \
        bf16_t* B3 = (bf16_t*)(ws + WS_B0 + 3 * BUFSZ); bf16_t* B4 = (bf16_t*)(ws + WS_B0 + 4 * BUFSZ); bf16_t* B5 = (bf16_t*)(ws + WS_B0 + 5 * BUFSZ); \
        float* LI = (float*)(ws + WS_LI); float* LF = (float*)(ws + WS_LF); bf16_t* XCs = (bf16_t*)(ws + WS_XC); const float* mods = (const float*)(ws + WS_MODS); \
        bf16_t* W1 = (bf16_t*)(ws + WS_W1); bf16_t* W2 = (bf16_t*)(ws + WS_W2); bf16_t* W3 = (bf16_t*)(ws + WS_W3); \
        (void)HMOD; (void)B0; (void)B1; (void)B2; (void)B3; (void)B4; (void)B5; (void)LI; (void)LF; (void)XCs; (void)mods; (void)W1; (void)W2; (void)W3;
#define PH_BAR(FIRST) { XcdBarrier bb = bar; { size_t z_ = 0; asm volatile("" : "+s"(z_), "+s"(bb.x)); bb.bar += z_; } xcd_barrier<FIRST>(bb); }
#define PH_END0  if (ph + 1 < p0.ph_hi) PH_BAR(true) } ++ph;
#define PH_END   if (ph + 1 < p0.ph_hi) PH_BAR(false) } ++ph;
#define PREP_EARLY(LAYER, BID, NB) do { const int jj_ = (LAYER) >> 1; \
        if (((LAYER) & 1) == 0) { phase_gfold(p, jj_, (bf16_t*)(ws + WS_WG), (BID), (NB)); \
            phase_transpose(lds, p.m_w_in + (size_t)jj_ * D * 6144, W1, D, 6144, 6144, 1, 0, 0, (BID), (NB)); \
            phase_transpose(lds, p.m_w_q + (size_t)jj_ * NH * DH * DH, W2, DH, DH, DH, NH, (size_t)DH * DH, (size_t)DH * DH, (BID), (NB)); \
            phase_transpose(lds, p.m_w_k + (size_t)jj_ * NH * DH * DH, W2 + (size_t)NH * DH * DH, DH, DH, DH, NH, (size_t)DH * DH, (size_t)DH * DH, (BID), (NB)); } \
        else { phase_transpose<1>(lds, p.f_w_in + (size_t)jj_ * D * 4096 + E, W1 + (size_t)2048 * D, D, E, 4096, 1, 0, 0, (BID), (NB)); } } while (0)
#define HMSR const bf16_t* HM = HMOD + (size_t)hf * TH * D; bf16_t* SR = HMOD + (size_t)(1 - hf) * TH * D; (void)HM; (void)SR;

template <int layer, int hf>
__device__ __forceinline__ void run_mlstm_half(const Params& p0, LAS unsigned char* lds, const XcdBarrier& bar, int& ph, const int G0, const int cid0) {
    constexpr int j = layer >> 1; constexpr bool upd_ctx = layer < 2, ctx_in = layer < 3;
    constexpr int rows_in = ctx_in ? TH : TLAT, rows_out = upd_ctx ? TH : TLAT;
    const int wo_units = (rows_out / 256) * 4, wo_busy = wo_units % G0;
    PH_BEGIN { HMSR pg8::Gemm g{HM, W1, TH, E, D, D, D, 1, 1, 0, 0, 0, 0, 0}; pg8::Order S; S.init(TH, E, 1, G, cid);
        pg8::EpiBf16 ep{B0, B0, 1, 0, (size_t)E, 1.0f, 1.0f}; pg8::gemm_phase(lds, g, S, ep); } PH_END
    PH_BEGIN phase_conv(p, j, B0, B1); PH_END
    PH_BEGIN { phase_gates(lds, B1, B0, (const bf16_t*)(ws + WS_WG), LI, LF, p.m_b_i + j * 8, p.m_b_f + j * 8);
        pg8::Gemm g{B1, W2, TH, DH, DH, E, DH, 8, 4, (size_t)DH, (size_t)DH * DH, 0, 0, 0}; pg8::Order S; S.init(TH, DH, 8, G, cid);
        pg8::EpiBf16 ep{B2, B3, 4, DH, (size_t)E, 1.0f, 0.044194173824159216f}; pg8::gemm_phase(lds, g, S, ep); } PH_END
    PH_BEGIN { HMSR pg8::Gemm g{B2, B3, TH, 256, DH, E, E, NH, NH, (size_t)DH, (size_t)DH, 1, 0, 0}; pg8::Order S; S.init(TH, 256, NH, G, cid);
        pg8::EpiSdiag ep{SR, SR + (size_t)HB * NH * 68 * 4096}; pg8::gemm_phase(lds, g, S, ep); } PH_END
    PH_BEGIN { HMSR phase_scan(lds, B2, B3, B0, SR, LI, LF, B4, B5); } PH_END
    PH_BEGIN phase_hstats(rows_out, B4, B5, LI); PH_END
    PH_BEGIN { HMSR pg8::Gemm g{HM, W1 + (size_t)E * D, rows_out, 2 * E, D, D, D, 1, 1, 0, 0, 0, E, 128}; pg8::Order S; S.init(rows_out, 2 * E, 1, G, cid);
        pg8::EpiMout ep{B4, B5, B1, LI, p.m_ln_w + (size_t)j * E, p.m_skip + (size_t)j * E, B0}; pg8::gemm_phase(lds, g, S, ep);
        if (hf == 0) { const int busy = ((rows_out / 256) * 16) % G;
            if (busy == 0) phase_hmod(p, layer, HB, TLAT, rows_in, HMOD + (size_t)TH * D, cid, G);
            else if (cid >= busy) phase_hmod(p, layer, HB, TLAT, rows_in, HMOD + (size_t)TH * D, cid - busy, G - busy); } } PH_END
    PH_BEGIN { pg8::Gemm g{B0, W3, rows_out, D, E, E, E, 1, 1, 0, 0, 0, 0, 0}; pg8::Order S; S.init(rows_out, D, 1, G, cid);
        pg8::EpiResid<layer == 0> er{p.x, p.ctx, (bf16_t*)p.out, XCs, mods + (size_t)layer * 9 * 3072, hf * HB, TLAT}; pg8::gemm_phase(lds, g, S, er);
        if (hf == 1) { if (wo_busy == 0) PREP_EARLY(layer + 1, cid, G); else if (cid >= wo_busy) PREP_EARLY(layer + 1, cid - wo_busy, G - wo_busy); } } PH_END
}
template <int layer>
__device__ __forceinline__ void run_layer(const Params& p0, LAS unsigned char* lds, const XcdBarrier& bar, int& ph, const int G0, const int cid0) {
    constexpr int j = layer >> 1;
    constexpr bool upd_ctx = layer < 2;
    constexpr bool ctx_in = layer < 3;
    if constexpr ((layer & 1) == 0) {
        constexpr int rows_in = ctx_in ? TH : TLAT;
        PH_BEGIN if (layer == 0) PREP_EARLY(0, cid, G);
            phase_transpose(lds, p.m_w_out + (size_t)j * E * D, W3, E, D, D, 1, 0, 0, cid, G);
            phase_hmod(p, layer, 0, TLAT, rows_in, HMOD, cid, G); PH_END
        run_mlstm_half<layer, 0>(p0, lds, bar, ph, G0, cid0);
        run_mlstm_half<layer, 1>(p0, lds, bar, ph, G0, cid0);
    } else {
        constexpr int TLF = NBATCH * SEQ;
        constexpr int rin = ctx_in ? (TLF + NBATCH * CTX) : TLF, rout = upd_ctx ? (TLF + NBATCH * CTX) : TLF;
        const int fo_busy = ((rout / 256) * 4) % G0;
        PH_BEGIN {
            phase_transpose<2>(lds, p.f_w_out + (size_t)j * E * D, W3, E, D, D, 1, 0, 0, cid, G);
            const GSeg sg[1] = {{p.f_w_in + (size_t)j * D * 4096, (const float*)(ws + WS_FC), 256}}; EpiFold ef{W1};
            gemm_generic<float, float, 1>(lds, sg, 4096, 256, D, 256, 8, 256, 0, ef);
            phase_hmod(p, layer, 0, TLF, rin, HMOD, cid, G); } PH_END
        PH_BEGIN { pg8::Gemm g{HMOD, W1, rin, YZW, D, D, D, 1, 1, 0, 0, 0, 0, 0}; pg8::Order S; S.init(rin, YZW, 1, G, cid);
            pg8::EpiBf16 ep{B0, B0, 1, 0, (size_t)YZW, 1.0f, 1.0f}; pg8::gemm_phase(lds, g, S, ep); } PH_END
        PH_BEGIN { phase_fft(lds, B0, B4, NBATCH); if (upd_ctx) phase_ctxdft(lds, B0, B4, NBATCH, TLF, (const bf16_t*)(ws + WS_TCTX)); } PH_END
        PH_BEGIN { pg8::Gemm g{B4, W3, rout, D, E, E, E, 1, 1, 0, 0, 0, 0, 0}; pg8::Order S; S.init(rout, D, 1, G, cid);
            pg8::EpiResid<false> er{p.x, p.ctx, (bf16_t*)p.out, XCs, mods + (size_t)layer * 9 * 3072, 0, TLF}; pg8::gemm_phase(lds, g, S, er);
            if (layer < 3) { if (fo_busy == 0) PREP_EARLY(layer + 1, cid, G); else if (cid >= fo_busy) PREP_EARLY(layer + 1, cid - fo_busy, G - fo_busy); } } PH_END
    }
}

__global__ void __launch_bounds__(NTHREADS, 2) mega(Params p0) {
    extern __shared__ __attribute__((aligned(16))) unsigned char smem[];
    LAS unsigned char* lds = (LAS unsigned char*)smem;
    if (threadIdx.x == 0) *(LAS u32x4*)(lds + L_BARW) = (u32x4){0u, 0u, 0u, 0u};
    __syncthreads();
    const bool single = (p0.ph_hi - p0.ph_lo) > 1;
    XcdBarrier bar; bar.bar = (unsigned*)(p0.ws + WS_BAR); bar.x = 0; bar.st = (volatile LAS unsigned*)(lds + L_BARW);
    if (single) bar = xcd_barrier_post((unsigned*)(p0.ws + WS_BAR), (volatile LAS unsigned*)(lds + L_BARW));
    int ph = 0;
    const int G0 = (int)gridDim.x, cid0 = (int)blockIdx.x;
    PH_BEGIN phase_mods(p, lds); phase_tables(p); PH_END0
    run_layer<0>(p0, lds, bar, ph, G0, cid0);
    run_layer<1>(p0, lds, bar, ph, G0, cid0);
    run_layer<2>(p0, lds, bar, ph, G0, cid0);
    run_layer<3>(p0, lds, bar, ph, G0, cid0);
    PH_BEGIN phase_final(p); PH_END
}

extern "C" void kernel_launch(void* const* d_in, const int* in_sizes, int n_in, void* d_out, int out_size, void* d_ws, size_t ws_size, hipStream_t stream) {
    static int ready = 0;
    if (!ready) {
        if (hipFuncSetAttribute((const void*)mega, hipFuncAttributeMaxDynamicSharedMemorySize, LDS_BYTES) != hipSuccess) fprintf(stderr, "hipFuncSetAttribute failed\n");
        (void)hipGetLastError();
        ready = 1;
    }
    (void)hipMemsetAsync((unsigned char*)d_ws + WS_BAR, 0, 16384, stream);
    Params p{};
    p.x = (const float*)d_in[0]; p.c = (const float*)d_in[1]; p.ctx = (const float*)d_in[2]; p.c_ctx = (const float*)d_in[3]; p.norm_g = (const float*)d_in[4];
    p.w_ada = (const float*)d_in[5]; p.b_ada = (const float*)d_in[6]; p.m_w_in = (const float*)d_in[7]; p.m_conv_w = (const float*)d_in[8]; p.m_conv_b = (const float*)d_in[9];
    p.m_w_q = (const float*)d_in[10]; p.m_w_k = (const float*)d_in[11]; p.m_w_if = (const float*)d_in[12]; p.m_b_i = (const float*)d_in[13]; p.m_b_f = (const float*)d_in[14];
    p.m_ln_w = (const float*)d_in[15]; p.m_skip = (const float*)d_in[16]; p.m_w_out = (const float*)d_in[17]; p.f_w_in = (const float*)d_in[18]; p.f_w_out = (const float*)d_in[19];
    p.norm_f = (const float*)d_in[20]; p.out = (float*)d_out; p.ws = (unsigned char*)d_ws;
    p.ph_lo = 0; p.ph_hi = 1000;
    hipLaunchKernelGGL(mega, dim3(256), dim3(NTHREADS), LDS_BYTES, stream, p);
}
```

```cpp
#include <hip/hip_runtime.h>
#include <stdint.h>
#include <stdio.h>

#define LAS __attribute__((address_space(3)))
typedef unsigned short bf16_t;
typedef short bf16x8 __attribute__((ext_vector_type(8)));
typedef float f32x4 __attribute__((ext_vector_type(4)));
typedef unsigned u32x4 __attribute__((ext_vector_type(4)));
typedef unsigned u32x2 __attribute__((ext_vector_type(2)));
typedef short s16x4 __attribute__((ext_vector_type(4)));

constexpr int D = 1024, E = 2048, SEQ = 4096, CTX = 256, NBATCH = 8, NH = 4, DH = 512;
constexpr int HB = 4;
constexpr int TLAT = HB * SEQ;
constexpr int TCTX = HB * CTX;
constexpr int TH = TLAT + TCTX;
constexpr int NTHREADS = 512;
constexpr float EPS = 1e-6f;

constexpr size_t al256(size_t x) { return (x + 255) & ~(size_t)255; }
constexpr size_t WS_BAR = 0;
constexpr size_t WS_MODS = 16384;
constexpr size_t WS_XC = al256(WS_MODS + (size_t)4 * 9 * 3072 * 4);
constexpr size_t WS_LI = al256(WS_XC + (size_t)NBATCH * CTX * D * 4);
constexpr size_t WS_LF = al256(WS_LI + (size_t)2 * TH * 4 * 4);
constexpr size_t WS_FC = al256(WS_LF + (size_t)2 * TH * 4 * 4);
constexpr size_t WS_TCTX = al256(WS_FC + (size_t)256 * 512 * 4);
constexpr size_t WS_WG = al256(WS_TCTX + (size_t)256 * 512 * 2);
constexpr size_t WS_W1 = al256(WS_WG + (size_t)6144 * 128 * 4);
constexpr size_t WS_W2 = al256(WS_W1 + (size_t)6144 * 1024 * 2);
constexpr size_t WS_W3 = al256(WS_W2 + (size_t)8 * 512 * 512 * 2);
constexpr size_t WS_HMOD = al256(WS_W3 + (size_t)1024 * 2048 * 2);
constexpr size_t BUFSZ = (size_t)TH * E * 2;
constexpr size_t WS_B0 = al256(WS_HMOD + (size_t)2 * TH * D * 2);
constexpr size_t WS_END = WS_B0 + 6 * BUFSZ;
static_assert(WS_END <= ((size_t)512 << 20), "workspace overflow");

constexpr int QROW = 1040;
constexpr int KROW = 1088;
constexpr int L_QS = 0, L_KS = 64 * QROW;
constexpr int L_SARR = 64 * QROW + 64 * KROW;
constexpr int L_SDEN = L_SARR + 2 * 5 * 256;
constexpr int L_ROWREC = L_SDEN + 2048 + 256 + 16;
constexpr int L_VS = L_ROWREC + 1024;
constexpr int L_XCH = L_VS + 8192;
constexpr int L_BARW = 163824;
constexpr int LDS_BYTES = L_BARW + 16;
static_assert(LDS_BYTES <= 160 * 1024 && L_XCH + 8192 <= L_BARW, "LDS overflow");

#define XB_TMO      128
#define XB_XCNT(j)  (256  + 64 * (j))
#define XB_XSUB(j)  (1280 + 64 * (j))
#define XB_XGEN(j)  (2304 + 64 * (j))
#define XB_TOP      3328
#define XB_TOPGEN   3392
#define XCD_BAR_WORDS 3456
#define XB_SPIN_CAP (1u << 22)

__device__ __forceinline__ unsigned xb_ld(unsigned* p)              { return __hip_atomic_load(p, __ATOMIC_RELAXED, __HIP_MEMORY_SCOPE_AGENT); }
__device__ __forceinline__ unsigned xb_add(unsigned* p, unsigned v) { return __hip_atomic_fetch_add(p, v, __ATOMIC_RELAXED, __HIP_MEMORY_SCOPE_AGENT); }
__device__ __forceinline__ unsigned xb_xcc_id() { return (unsigned)__builtin_amdgcn_s_getreg((3 << 11) | 20) & 0xFu; }
#define XB_SPIN(cond, bar) do { unsigned _sp = 0; while (cond) { __builtin_amdgcn_s_sleep(1); \
    if ((++_sp & 255u) == 0u) { if (xb_ld(&(bar)[XB_TMO])) break; if (_sp > XB_SPIN_CAP) { atomicAdd(&(bar)[XB_TMO], 1u); break; } } } } while (0)

struct XcdBarrier { unsigned* bar; unsigned x; volatile LAS unsigned* st; };

__device__ __forceinline__ XcdBarrier xcd_barrier_post(unsigned* bar, volatile LAS unsigned* st) {
    XcdBarrier b; b.bar = bar; b.x = xb_xcc_id(); b.st = st;
    if (threadIdx.x == 0) (void)xb_add(&bar[XB_XCNT(b.x)], 1u);
    return b;
}
__device__ __forceinline__ void xcd_barrier_complete(unsigned* bar, unsigned x, unsigned& nloc, unsigned& nx) {
    const unsigned G = gridDim.x * gridDim.y * gridDim.z;
    unsigned sum, cnt, mine, sp = 0u;
    for (;;) {
        sum = 0u; cnt = 0u; mine = 0u;
#pragma unroll
        for (unsigned j = 0; j < 16; ++j) { const unsigned c = xb_ld(&bar[XB_XCNT(j)]); sum += c; cnt += (c > 0u) ? 1u : 0u; mine = (j == x) ? c : mine; }
        if (sum == G) break;
        __builtin_amdgcn_s_sleep(1);
        if ((++sp & 255u) == 0u) { if (xb_ld(&bar[XB_TMO])) break; if (sp > XB_SPIN_CAP) { atomicAdd(&bar[XB_TMO], 1u); break; } }
    }
    nloc = mine > 0u ? mine : 1u; nx = cnt > 0u ? cnt : 1u;
}
template <bool FIRST>
__device__ __forceinline__ void xcd_barrier(const XcdBarrier& b) {
    asm volatile("s_waitcnt vmcnt(0)" ::: "memory");
    __syncthreads();
    if (threadIdx.x == 0) {
        unsigned* bar = b.bar;
        __builtin_amdgcn_s_waitcnt(0);
        unsigned nloc = b.st[0], nx = b.st[1];
        if (FIRST) { if (nloc == 0u) { xcd_barrier_complete(bar, b.x, nloc, nx); b.st[0] = nloc; b.st[1] = nx; } }
        const unsigned old = xb_add(&bar[XB_XSUB(b.x)], 1u);
        const unsigned gen = old / nloc;
        if (old + 1u == (gen + 1u) * nloc) {
            __builtin_amdgcn_fence(__ATOMIC_RELEASE, "agent");
            asm volatile("s_waitcnt vmcnt(0)" ::: "memory");
            const unsigned og = xb_add(&bar[XB_TOP], 1u);
            const unsigned tg = og / nx;
            if (og + 1u == (tg + 1u) * nx) xb_add(&bar[XB_TOPGEN], 1u);
            else XB_SPIN(xb_ld(&bar[XB_TOPGEN]) == tg, bar);
            __builtin_amdgcn_fence(__ATOMIC_ACQUIRE, "agent");
            xb_add(&bar[XB_XGEN(b.x)], 1u);
            asm volatile("s_waitcnt vmcnt(0)" ::: "memory");
        } else {
            XB_SPIN(xb_ld(&bar[XB_XGEN(b.x)]) == gen, bar);
            __builtin_amdgcn_fence(__ATOMIC_ACQUIRE, "agent");
            asm volatile("s_waitcnt vmcnt(0)" ::: "memory");
        }
    }
    __syncthreads();
}

typedef float f32x2 __attribute__((ext_vector_type(2)));
typedef __bf16 bf16x2_t __attribute__((ext_vector_type(2)));
__device__ __forceinline__ unsigned pack2(float lo, float hi) { const f32x2 f = {lo, hi}; const bf16x2_t h = __builtin_convertvector(f, bf16x2_t); return __builtin_bit_cast(unsigned, h); }
__device__ __forceinline__ bf16_t f2bf(float f) { return (bf16_t)(pack2(f, 0.f) & 0xffffu); }
__device__ __forceinline__ float bf2f(bf16_t b) { return __uint_as_float(((unsigned)b) << 16); }
__device__ __forceinline__ float silu_f(float v) { return v / (1.0f + __expf(-v)); }
__device__ __forceinline__ float sigmoid_f(float v) { return 1.0f / (1.0f + __expf(-v)); }
__device__ __forceinline__ float bfw(const unsigned (&w)[4], int i) { return bf2f((bf16_t)((i & 1) ? (w[i >> 1] >> 16) : (w[i >> 1] & 0xffffu))); }
#define DPP_F(v, ctrl, rmask, bc) __builtin_bit_cast(float, __builtin_amdgcn_update_dpp(0, __builtin_bit_cast(int, (v)), (ctrl), (rmask), 0xf, (bc)))
__device__ __forceinline__ float wave_sum(float v) {
    v += DPP_F(v, 0xB1, 0xf, true); v += DPP_F(v, 0x4E, 0xf, true); v += DPP_F(v, 0x141, 0xf, true); v += DPP_F(v, 0x140, 0xf, true);
    const int iv = __builtin_bit_cast(int, v);
    return (__builtin_bit_cast(float, __builtin_amdgcn_readlane(iv, 0)) + __builtin_bit_cast(float, __builtin_amdgcn_readlane(iv, 16)))
         + (__builtin_bit_cast(float, __builtin_amdgcn_readlane(iv, 32)) + __builtin_bit_cast(float, __builtin_amdgcn_readlane(iv, 48)));
}
__device__ __forceinline__ float wave_scan_sum(float v) {
    v += DPP_F(v, 0x111, 0xf, true); v += DPP_F(v, 0x112, 0xf, true); v += DPP_F(v, 0x114, 0xf, true); v += DPP_F(v, 0x118, 0xf, true);
    v += DPP_F(v, 0x142, 0xa, false); v += DPP_F(v, 0x143, 0xc, false);
    return v;
}
#define DPP_FM(v, ctrl, rmask) __builtin_bit_cast(float, __builtin_amdgcn_update_dpp((int)0xff800000, __builtin_bit_cast(int, (v)), (ctrl), (rmask), 0xf, false))
__device__ __forceinline__ float wave_scan_max(float v) {
    v = fmaxf(v, DPP_FM(v, 0x111, 0xf)); v = fmaxf(v, DPP_FM(v, 0x112, 0xf)); v = fmaxf(v, DPP_FM(v, 0x114, 0xf)); v = fmaxf(v, DPP_FM(v, 0x118, 0xf));
    v = fmaxf(v, DPP_FM(v, 0x142, 0xa)); v = fmaxf(v, DPP_FM(v, 0x143, 0xc));
    return v;
}
__device__ __forceinline__ int opq_tid() { int t = threadIdx.x; asm volatile("" : "+v"(t)); return t; }

struct Params {
    const float* x; const float* c; const float* ctx; const float* c_ctx; const float* norm_g; const float* w_ada; const float* b_ada;
    const float* m_w_in; const float* m_conv_w; const float* m_conv_b; const float* m_w_q; const float* m_w_k; const float* m_w_if;
    const float* m_b_i; const float* m_b_f; const float* m_ln_w; const float* m_skip; const float* m_w_out; const float* f_w_in; const float* f_w_out;
    const float* norm_f; float* out; unsigned char* ws; int ph_lo; int ph_hi;
};

struct GSeg { const void* A; const void* B; int K; };
template <typename T> __device__ __forceinline__ void load8_bf16(const T* p, unsigned (&w)[4]);
template <> __device__ __forceinline__ void load8_bf16<float>(const float* p, unsigned (&w)[4]) {
    const float4 a = *(const float4*)p, b = *(const float4*)(p + 4);
    w[0] = pack2(a.x, a.y); w[1] = pack2(a.z, a.w); w[2] = pack2(b.x, b.y); w[3] = pack2(b.z, b.w);
}
template <> __device__ __forceinline__ void load8_bf16<bf16_t>(const bf16_t* p, unsigned (&w)[4]) {
    const uint4 a = *(const uint4*)p; w[0] = a.x; w[1] = a.y; w[2] = a.z; w[3] = a.w;
}
template <typename TA, typename TB, int NSEG, class Epi, bool BCOL2 = false>
__device__ __forceinline__ void gemm_generic(LAS unsigned char* lds, const GSeg (&seg)[NSEG], size_t lda, size_t ldb, int M, int N, int nbatch, size_t sA, size_t sB, const Epi& epi) {
    const int tid = opq_tid(), lane = tid & 63, w = tid >> 6, fr = lane & 15, fq = lane >> 4, wm = w >> 2, wn = w & 3;
    LAS unsigned char* As = lds; LAS unsigned char* Bs = lds + 128 * 80;
    const int tm = M / 128, tn = N / 128, ntile = nbatch * tm * tn;
    const int arow = tid >> 2, ac8 = (tid & 3) * 8, bk = tid >> 4, bn8 = (tid & 15) * 8;
    for (int tile = blockIdx.x; tile < ntile; tile += gridDim.x) {
        const int batch = tile / (tm * tn), rem = tile % (tm * tn), m0 = (rem / tn) * 128, n0 = (rem % tn) * 128;
        f32x4 acc[4][2];
#pragma unroll
        for (int i = 0; i < 4; ++i)
#pragma unroll
            for (int j = 0; j < 2; ++j) acc[i][j] = (f32x4){0.f, 0.f, 0.f, 0.f};
#pragma unroll
        for (int sg = 0; sg < NSEG; ++sg) {
            const TA* Ab = (const TA*)seg[sg].A + batch * sA + (size_t)(m0 + arow) * lda + ac8;
            const TB* Bb = (const TB*)seg[sg].B + batch * sB + (size_t)bk * ldb + (BCOL2 ? 2 : 1) * (n0 + bn8);
            for (int k0 = 0; k0 < seg[sg].K; k0 += 32) {
                unsigned aw[4], bw[4];
                load8_bf16<TA>(Ab + k0, aw);
                load8_bf16<TB>(Bb + (size_t)k0 * ldb, bw);
                __syncthreads();
                *(LAS u32x4*)(As + arow * 80 + ac8 * 2) = (u32x4){aw[0], aw[1], aw[2], aw[3]};
#pragma unroll
                for (int i = 0; i < 4; ++i) {
                    *(LAS bf16_t*)(Bs + (bn8 + 2 * i) * 80 + bk * 2) = (bf16_t)(bw[i] & 0xffffu);
                    *(LAS bf16_t*)(Bs + (bn8 + 2 * i + 1) * 80 + bk * 2) = (bf16_t)(bw[i] >> 16);
                }
                __syncthreads();
                bf16x8 af[4], bfr[2];
#pragma unroll
                for (int i = 0; i < 4; ++i) af[i] = *(const LAS bf16x8*)(As + (wm * 64 + i * 16 + fr) * 80 + fq * 16);
#pragma unroll
                for (int j = 0; j < 2; ++j) bfr[j] = *(const LAS bf16x8*)(Bs + (wn * 32 + j * 16 + fr) * 80 + fq * 16);
#pragma unroll
                for (int i = 0; i < 4; ++i)
#pragma unroll
                    for (int j = 0; j < 2; ++j) acc[i][j] = __builtin_amdgcn_mfma_f32_16x16x32_bf16(af[i], bfr[j], acc[i][j], 0, 0, 0);
            }
        }
#pragma unroll
        for (int i = 0; i < 4; ++i)
#pragma unroll
            for (int j = 0; j < 2; ++j)
#pragma unroll
                for (int r = 0; r < 4; ++r) epi(batch, m0 + wm * 64 + i * 16 + fq * 4 + r, n0 + wn * 32 + j * 16 + fr, acc[i][j][r]);
    }
    __syncthreads();
}


namespace pg8 {
constexpr int BM = 256, BK = 64, HALF = 128, HTB = HALF * BK * 2, NXCD = 8, WGM = 8;
__device__ __forceinline__ int lds_byte(int r, int c) { const int st = (r >> 4) * 2 + (c >> 5), rr = r & 15, cc = c & 31, ob = rr * 64 + cc * 2; return st * 1024 + (ob ^ (((ob >> 9) & 1) << 5)); }
__device__ __forceinline__ void stage_rc(int b, int& R, int& C) { const int st = b / 1024, sb = b % 1024, swz = sb ^ (((sb >> 9) & 1) << 5); R = (st >> 1) * 16 + swz / 64; C = (st & 1) * 32 + (swz % 64) / 2; }
__device__ __forceinline__ int perm32(int rho) { const int n = rho >> 4, i = rho & 15; return 8 * (i >> 2) + 4 * n + (i & 3); }
struct Unit { int pm, pn, b; };
struct Gemm { const bf16_t* A; const bf16_t* Bt; int M, N, K, lda, ldb, nb, nbA; size_t sAb, sBb; int diag; int bh_rows, bt_rows; };
struct Order {
    int nM, nN, nwg, G, c;
    __device__ void init(int M, int N, int nb, int G_, int c_) { nM = M / BM; nN = N / BM; nwg = nb * nM * nN; G = G_; c = c_; }
    __device__ bool next(int i, Unit& u) const {
        const long L = (long)i * G + c; if (L >= nwg) return false;
        int wgid = (int)L; { const int q = nwg / NXCD, r = nwg % NXCD, xcd = wgid % NXCD, off = wgid / NXCD; wgid = (xcd < r ? xcd * (q + 1) : r * (q + 1) + (xcd - r) * q) + off; }
        const int nMv = nwg / nN, nig = WGM * nN, gid = wgid / nig, fm = gid * WGM, gsz = (nMv - fm) < WGM ? (nMv - fm) : WGM;
        const int vm = fm + ((wgid % nig) % gsz); u.pn = (wgid % nig) / gsz; u.b = vm / nM; u.pm = vm % nM; return true;
    }
};
__device__ __forceinline__ unsigned cvt_pk_bf16(float lo, float hi) { unsigned r; asm volatile("v_cvt_pk_bf16_f32 %0, %1, %2" : "=v"(r) : "v"(lo), "v"(hi)); return r; }

template <class Epi>
__device__ __forceinline__ void gemm_phase(LAS unsigned char* lds, const Gemm g, const Order& S, const Epi& E) {
    const int tid = opq_tid(), wid = __builtin_amdgcn_readfirstlane(tid >> 6), lane = tid & 63, wr = wid >> 2, wc = wid & 3, fr = lane & 15, fq = lane >> 4;
    const int K = g.K, nt = K / BK;
    unsigned voffA[2], voffB[2];
#pragma unroll
    for (int i = 0; i < 2; ++i) { int R, C; stage_rc(tid * 16 + i * 8192, R, C); const int Rb = Epi::PERM ? ((R & ~31) + perm32(R & 31)) : R;
        voffA[i] = (unsigned)(R * g.lda + C) * 2u; voffB[i] = (unsigned)(Rb * g.ldb + C) * 2u; }
    const size_t kstep = (size_t)(BK * 2);
    const size_t hstepA = (size_t)HALF * g.lda * 2, hstepB = (size_t)(g.bh_rows ? g.bh_rows : HALF) * g.ldb * 2;
    const size_t tstepA = 2 * hstepA, tstepB = (size_t)(g.bt_rows ? g.bt_rows : 2 * HALF) * g.ldb * 2;
    const unsigned ldsw = (unsigned)wid * 1024u;
    const int aoff = lds_byte(wr * 64 + fr, fq * 8), boff = lds_byte(wc * 32 + fr, fq * 8);
#define PG8_SA(b, h) (((b) * 2 + (h)) * HTB)
#define PG8_SB(b, h) ((4 + (b) * 2 + (h)) * HTB)
#define PG8_STAGE(bufoff, gbase, voff) do { _Pragma("unroll") for (int _i = 0; _i < 2; ++_i) \
        __builtin_amdgcn_global_load_lds((const unsigned*)((const char*)(gbase) + (voff)[_i]), (LAS unsigned*)(lds + (bufoff) + ldsw + _i * 8192), 16, 0, 0); } while (0)
#define PG8_LDA(dst, b, h) do { _Pragma("unroll") for (int m = 0; m < 4; ++m) _Pragma("unroll") for (int k = 0; k < 2; ++k) dst[m][k] = *(const LAS bf16x8*)(lds + PG8_SA(b, h) + aoff + m * 2048 + k * 1024); } while (0)
#define PG8_LDB(dst, b, h) do { _Pragma("unroll") for (int n = 0; n < 2; ++n) _Pragma("unroll") for (int k = 0; k < 2; ++k) dst[n][k] = *(const LAS bf16x8*)(lds + PG8_SB(b, h) + boff + n * 2048 + k * 1024); } while (0)
#define PG8_MMA(ai, bj, At, Bt) do { __builtin_amdgcn_s_setprio(1); _Pragma("unroll") for (int m = 0; m < 4; ++m) _Pragma("unroll") for (int n = 0; n < 2; ++n) _Pragma("unroll") for (int k = 0; k < 2; ++k) \
        acc[ai][bj][m][n] = __builtin_amdgcn_mfma_f32_16x16x32_bf16(Bt[n][k], At[m][k], acc[ai][bj][m][n], 0, 0, 0); __builtin_amdgcn_s_setprio(0); } while (0)
#define PG8_WAIT_V(n) asm volatile("s_waitcnt vmcnt(" #n ")" ::: "memory")
#define PG8_WAIT_L(n) asm volatile("s_waitcnt lgkmcnt(" #n ")" ::: "memory")
#define PG8_WAIT_VE do { if (Epi::NVM == 16) asm volatile("s_waitcnt vmcnt(22)" ::: "memory"); else if (Epi::NVM == 8) asm volatile("s_waitcnt vmcnt(14)" ::: "memory"); else if (Epi::NVM == 32) asm volatile("s_waitcnt vmcnt(38)" ::: "memory"); else asm volatile("s_waitcnt vmcnt(6)" ::: "memory"); } while (0)
#define PG8_BAR __builtin_amdgcn_s_barrier()
#define PG8_SCHED __builtin_amdgcn_sched_barrier(0)
#define PG8_KSTEP(t, PRE) do { \
            const bool last = ((t) == nt - 2); \
            const char* a1 = cA + (size_t)((t) + 1) * kstep; \
            const char* a2 = last ? nA : cA + (size_t)((t) + 2) * kstep; const char* b2 = last ? nB : cB + (size_t)((t) + 2) * kstep; \
            const char* a3 = a2 + kstep; const char* b3 = b2 + kstep; \
            PG8_LDB(B0, 0, 0); PG8_SCHED; PG8_LDA(At, 0, 0); if (!(PRE)) PG8_STAGE(PG8_SA(1, 1), a1 + hstepA, voffA); \
            PG8_WAIT_L(8); PG8_BAR; PG8_WAIT_L(0); PG8_MMA(0, 0, At, B0); PG8_BAR; PG8_SCHED; \
            PG8_LDB(B1, 0, 1); PG8_STAGE(PG8_SB(0, 0), b2, voffB); \
            PG8_BAR; PG8_WAIT_L(0); if (!g.diag) PG8_MMA(0, 1, At, B1); PG8_BAR; \
            PG8_LDA(At, 0, 1); PG8_STAGE(PG8_SA(0, 0), a2, voffA); \
            PG8_BAR; PG8_WAIT_L(0); if (!g.diag) PG8_MMA(1, 0, At, B0); PG8_BAR; PG8_SCHED; \
            PG8_STAGE(PG8_SB(0, 1), b2 + hstepB, voffB); \
            if (PRE) PG8_WAIT_VE; else PG8_WAIT_V(6); PG8_BAR; PG8_MMA(1, 1, At, B1); PG8_BAR; \
            PG8_LDB(B0, 1, 0); PG8_SCHED; PG8_LDA(At, 1, 0); PG8_STAGE(PG8_SA(0, 1), a2 + hstepA, voffA); \
            PG8_WAIT_L(8); PG8_BAR; PG8_WAIT_L(0); PG8_MMA(0, 0, At, B0); PG8_BAR; PG8_SCHED; \
            PG8_LDB(B1, 1, 1); PG8_STAGE(PG8_SB(1, 0), b3, voffB); \
            PG8_BAR; PG8_WAIT_L(0); if (!g.diag) PG8_MMA(0, 1, At, B1); PG8_BAR; \
            PG8_LDA(At, 1, 1); PG8_STAGE(PG8_SA(1, 0), a3, voffA); \
            PG8_BAR; PG8_WAIT_L(0); if (!g.diag) PG8_MMA(1, 0, At, B0); PG8_BAR; PG8_SCHED; \
            PG8_STAGE(PG8_SB(1, 1), b3 + hstepB, voffB); \
            PG8_WAIT_V(6); PG8_BAR; PG8_MMA(1, 1, At, B1); PG8_BAR; } while (0)
#define PG8_ZERO_ACC do { _Pragma("unroll") for (int a = 0; a < 2; ++a) _Pragma("unroll") for (int b = 0; b < 2; ++b) _Pragma("unroll") for (int m = 0; m < 4; ++m) \
        _Pragma("unroll") for (int n = 0; n < 2; ++n) { acc[a][b][m][n] = (f32x4){0.f, 0.f, 0.f, 0.f}; asm volatile("" : "+v"(acc[a][b][m][n])); } } while (0)
#define PG8_NEXT_PTRS do { has_next = S.next(ui + 1, nxt); \
        nA = has_next ? (const char*)(g.A + (size_t)(nxt.b % g.nbA) * g.sAb) + (size_t)nxt.pm * tstepA : cA; \
        nB = has_next ? (const char*)(g.Bt + (size_t)nxt.b * g.sBb) + (size_t)(g.diag ? nxt.pm : nxt.pn) * tstepB : cB; } while (0)
    Unit cur, nxt; int ui = 0;
    if (!S.next(0, cur)) return;
    f32x4 acc[2][2][4][2];
    PG8_ZERO_ACC;
    bf16x8 At[4][2], B0[2][2], B1[2][2];
    const char* cA = (const char*)(g.A + (size_t)(cur.b % g.nbA) * g.sAb) + (size_t)cur.pm * tstepA; const char* cB = (const char*)(g.Bt + (size_t)cur.b * g.sBb) + (size_t)(g.diag ? cur.pm : cur.pn) * tstepB;
    PG8_STAGE(PG8_SB(0, 0), cB, voffB); PG8_STAGE(PG8_SA(0, 0), cA, voffA); PG8_STAGE(PG8_SB(0, 1), cB + hstepB, voffB); PG8_STAGE(PG8_SA(0, 1), cA + hstepA, voffA);
    if (wr == 1) PG8_BAR;
    PG8_WAIT_V(4); PG8_BAR;
    PG8_STAGE(PG8_SB(1, 0), cB + kstep, voffB); PG8_STAGE(PG8_SA(1, 0), cA + kstep, voffA); PG8_STAGE(PG8_SB(1, 1), cB + hstepB + kstep, voffB);
    PG8_WAIT_V(6); PG8_BAR;
    bool has_next; const char* nA; const char* nB;
    PG8_NEXT_PTRS;
    for (int t = 0; t < nt; t += 2) PG8_KSTEP(t, false);
    for (;;) {
        if (Epi::NVM > 0) { PG8_STAGE(PG8_SA(1, 1), nA + kstep + hstepA, voffA); PG8_SCHED; }
        E(acc, cur, wr, wc, fr, fq);
        PG8_SCHED;
        if (!has_next) break;
        PG8_ZERO_ACC;
        cur = nxt; cA = nA; cB = nB; ++ui;
        PG8_NEXT_PTRS;
        if (Epi::NVM > 0) { PG8_KSTEP(0, true); for (int t = 2; t < nt; t += 2) PG8_KSTEP(t, false); }
        else { for (int t = 0; t < nt; t += 2) PG8_KSTEP(t, false); }
    }
    PG8_WAIT_V(0);
    if (wr == 0) PG8_BAR;
    PG8_BAR;
#undef PG8_SA
#undef PG8_SB
#undef PG8_STAGE
#undef PG8_LDA
#undef PG8_LDB
#undef PG8_MMA
#undef PG8_WAIT_V
#undef PG8_WAIT_L
#undef PG8_WAIT_VE
#undef PG8_KSTEP
#undef PG8_ZERO_ACC
#undef PG8_NEXT_PTRS
#undef PG8_BAR
#undef PG8_SCHED
}
struct EpiBf16 {
    static constexpr bool PERM = true; static constexpr int NVM = 16;
    bf16_t* O0; bf16_t* O1; int nb0; int bcols; size_t ldc; float s0, s1;
    __device__ __forceinline__ void operator()(const f32x4 (&acc)[2][2][4][2], const Unit& u, int wr, int wc, int fr, int fq) const {
        const bool second = u.b >= nb0; bf16_t* O = second ? O1 : O0; const float sc = second ? s1 : s0; const int bb = second ? u.b - nb0 : u.b;
        const int row0 = u.pm * BM + wr * 64 + fr, col0 = bb * bcols + u.pn * BM + wc * 32 + 8 * fq;
#pragma unroll
        for (int ai = 0; ai < 2; ++ai)
#pragma unroll
            for (int m = 0; m < 4; ++m) { bf16_t* rowp = O + (size_t)(row0 + ai * HALF + m * 16) * ldc + col0;
#pragma unroll
                for (int bj = 0; bj < 2; ++bj) { const f32x4 v0 = acc[ai][bj][m][0] * sc, v1 = acc[ai][bj][m][1] * sc;
                    u32x4 w; w.x = cvt_pk_bf16(v0[0], v0[1]); w.y = cvt_pk_bf16(v0[2], v0[3]); w.z = cvt_pk_bf16(v1[0], v1[1]); w.w = cvt_pk_bf16(v1[2], v1[3]);
                    *(u32x4*)(rowp + bj * HALF) = w; } }
    }
};
struct EpiSplitOZ {
    static constexpr bool PERM = true; static constexpr int NVM = 16;
    bf16_t* O0; bf16_t* O1;
    __device__ __forceinline__ void operator()(const f32x4 (&acc)[2][2][4][2], const Unit& u, int wr, int wc, int fr, int fq) const {
        const int ct = u.pn * BM; bf16_t* O = (ct < E) ? O0 : O1; const int row0 = u.pm * BM + wr * 64 + fr, col0 = (ct & (E - 1)) + wc * 32 + 8 * fq;
#pragma unroll
        for (int ai = 0; ai < 2; ++ai)
#pragma unroll
            for (int m = 0; m < 4; ++m) { bf16_t* rowp = O + (size_t)(row0 + ai * HALF + m * 16) * E + col0;
#pragma unroll
                for (int bj = 0; bj < 2; ++bj) { const f32x4 v0 = acc[ai][bj][m][0], v1 = acc[ai][bj][m][1];
                    u32x4 w; w.x = cvt_pk_bf16(v0[0], v0[1]); w.y = cvt_pk_bf16(v0[2], v0[3]); w.z = cvt_pk_bf16(v1[0], v1[1]); w.w = cvt_pk_bf16(v1[2], v1[3]);
                    *(u32x4*)(rowp + bj * HALF) = w; } }
    }
};
struct EpiMout {
    static constexpr bool PERM = true; static constexpr int NVM = 8;
    const bf16_t* Hf; const bf16_t* Hr; const bf16_t* XCV; const float* stats; const float* lnw; const float* skp; bf16_t* Y;
    __device__ __forceinline__ void operator()(f32x4 (&acc)[2][2][4][2], const Unit& u, int wr, int wc, int fr, int fq) const {
        const int f0 = u.pn * HALF + wc * 32 + 8 * fq, head = f0 >> 9, row0 = u.pm * BM + wr * 64 + fr;
        const f32x4 lw0 = *(const f32x4*)(lnw + f0), lw1 = *(const f32x4*)(lnw + f0 + 4), sk0 = *(const f32x4*)(skp + f0), sk1 = *(const f32x4*)(skp + f0 + 4);
        u32x4 a[4], b[4], xv[4]; f32x2 st[4]; u32x4 yo[4];
#define EM_LOAD(ai) do { _Pragma("unroll") for (int m = 0; m < 4; ++m) { const int row = row0 + (ai) * HALF + m * 16; const size_t off = (size_t)row * E + f0; \
            a[m] = *(const u32x4*)(Hf + off); b[m] = *(const u32x4*)(Hr + off); xv[m] = *(const u32x4*)(XCV + off); st[m] = *(const f32x2*)(stats + ((size_t)row * NH + head) * 2); } } while (0)
#define EM_GATE(ai) do { _Pragma("unroll") for (int m = 0; m < 4; ++m) _Pragma("unroll") for (int n = 0; n < 2; ++n) _Pragma("unroll") for (int e = 0; e < 4; ++e) { \
            acc[ai][0][m][n][e] = sigmoid_f(acc[ai][0][m][n][e]); acc[ai][1][m][n][e] = silu_f(acc[ai][1][m][n][e]); } } while (0)
#define EM_COMB(ai) do { _Pragma("unroll") for (int m = 0; m < 4; ++m) { \
            const unsigned aw[4] = {a[m].x, a[m].y, a[m].z, a[m].w}, bw[4] = {b[m].x, b[m].y, b[m].z, b[m].w}, xw[4] = {xv[m].x, xv[m].y, xv[m].z, xv[m].w}; \
            const f32x4 o0 = acc[ai][0][m][0], o1 = acc[ai][0][m][1], z0 = acc[ai][1][m][0], z1 = acc[ai][1][m][1]; float y[8]; \
            _Pragma("unroll") for (int i = 0; i < 8; ++i) { const float so = (i < 4) ? o0[i & 3] : o1[i & 3], sz = (i < 4) ? z0[i & 3] : z1[i & 3], lw = (i < 4) ? lw0[i & 3] : lw1[i & 3], sk = (i < 4) ? sk0[i & 3] : sk1[i & 3]; \
                const float hn = (bfw(aw, i) + bfw(bw, i) - st[m][0]) * st[m][1] * lw * so; y[i] = (hn + sk * bfw(xw, i)) * sz; } \
            yo[m].x = cvt_pk_bf16(y[0], y[1]); yo[m].y = cvt_pk_bf16(y[2], y[3]); yo[m].z = cvt_pk_bf16(y[4], y[5]); yo[m].w = cvt_pk_bf16(y[6], y[7]); } } while (0)
#define EM_STORE(ai) do { _Pragma("unroll") for (int m = 0; m < 4; ++m) { const int row = row0 + (ai) * HALF + m * 16; *(u32x4*)(Y + (size_t)row * E + f0) = yo[m]; } } while (0)
        EM_LOAD(0); __builtin_amdgcn_sched_barrier(0); EM_GATE(0); __builtin_amdgcn_sched_barrier(0); EM_COMB(0);
        __builtin_amdgcn_sched_barrier(0); EM_LOAD(1); __builtin_amdgcn_sched_barrier(0); EM_STORE(0); __builtin_amdgcn_sched_barrier(0);
        EM_GATE(1); __builtin_amdgcn_sched_barrier(0); EM_COMB(1); EM_STORE(1);
#undef EM_LOAD
#undef EM_GATE
#undef EM_COMB
#undef EM_STORE
    }
};
template <bool SRCF>
struct EpiResid {
    static constexpr bool PERM = true; static constexpr int NVM = 16;
    const float* xlat_f; const float* xctx_f; bf16_t* xlat; bf16_t* xctx; const float* mods_layer; int b0; int tlat;
    __device__ __forceinline__ void operator()(const f32x4 (&acc)[2][2][4][2], const Unit& u, int wr, int wc, int fr, int fq) const {
        const int rt = u.pm * BM, col0 = u.pn * BM + wc * 32 + 8 * fq;
        const bool lat = rt < tlat; const int b = b0 + (lat ? (rt >> 12) : ((rt - tlat) >> 8));
        const int r0 = (lat ? (rt & 4095) : 0) + wr * 64 + fr;
        const float* gv = mods_layer + (size_t)(lat ? b : 8) * 3072 + 2048 + col0;
        const f32x4 g00 = *(const f32x4*)(gv), g01 = *(const f32x4*)(gv + 4), g10 = *(const f32x4*)(gv + HALF), g11 = *(const f32x4*)(gv + HALF + 4);
        const size_t rbase = lat ? (size_t)b * SEQ : (size_t)b * CTX;
        const float* sf = (lat ? xlat_f : xctx_f) + (rbase + r0) * D + col0;
        bf16_t* sb = lat ? (xlat + (rbase + r0) * (2 * D) + col0) : (xctx + (rbase + r0) * D + col0);
        const size_t rsb = lat ? (size_t)2 * D : (size_t)D;
#pragma unroll
        for (int ai = 0; ai < 2; ++ai) {
            f32x4 xf[4][2][2]; u32x4 xb[4][2];
#pragma unroll
            for (int m = 0; m < 4; ++m) { const int dr = ai * HALF + m * 16;
#pragma unroll
                for (int bj = 0; bj < 2; ++bj) {
                    if (SRCF) { xf[m][bj][0] = *(const f32x4*)(sf + (size_t)dr * D + bj * HALF); xf[m][bj][1] = *(const f32x4*)(sf + (size_t)dr * D + bj * HALF + 4); }
                    else xb[m][bj] = *(const u32x4*)(sb + dr * rsb + bj * HALF); } }
            __builtin_amdgcn_sched_barrier(0);
#pragma unroll
            for (int m = 0; m < 4; ++m) { const int dr = ai * HALF + m * 16;
#pragma unroll
                for (int bj = 0; bj < 2; ++bj) { f32x4 x0, x1;
                    if (SRCF) { x0 = xf[m][bj][0]; x1 = xf[m][bj][1]; }
                    else { const u32x4 xw = xb[m][bj];
                        x0 = (f32x4){__uint_as_float(xw.x << 16), __uint_as_float(xw.x & 0xffff0000u), __uint_as_float(xw.y << 16), __uint_as_float(xw.y & 0xffff0000u)};
                        x1 = (f32x4){__uint_as_float(xw.z << 16), __uint_as_float(xw.z & 0xffff0000u), __uint_as_float(xw.w << 16), __uint_as_float(xw.w & 0xffff0000u)}; }
                    const f32x4 v0 = x0 + (bj ? g10 : g00) * acc[ai][bj][m][0], v1 = x1 + (bj ? g11 : g01) * acc[ai][bj][m][1];
                    u32x4 w; w.x = cvt_pk_bf16(v0[0], v0[1]); w.y = cvt_pk_bf16(v0[2], v0[3]); w.z = cvt_pk_bf16(v1[0], v1[1]); w.w = cvt_pk_bf16(v1[2], v1[3]);
                    *(u32x4*)(sb + dr * rsb + bj * HALF) = w; } }
        }
    }
};
struct EpiSdiag {
    static constexpr bool PERM = true; static constexpr int NVM = 0;
    bf16_t* S; bf16_t* R;
    __device__ __forceinline__ void operator()(const f32x4 (&acc)[2][2][4][2], const Unit& u, int wr, int wc, int fr, int fq) const {
        if (wr != (wc >> 1)) return;
        const int bl = (u.pm < 64) ? (u.pm >> 4) : (u.pm - 64), ch0 = (u.pm < 64) ? (4 + (u.pm & 15) * 4) : 0;
        const int ss0 = (wc & 1) * 32 + 8 * fq;
#pragma unroll
        for (int ai = 0; ai < 2; ++ai) { const int ci = ch0 + 2 * ai + wr, cr = (ci < 4) ? (3 - ci) : (71 - ci);
            bf16_t* bf = S + ((size_t)((bl * NH + u.b) * 68 + ci) * 64) * 64; bf16_t* br = R + ((size_t)((bl * NH + u.b) * 68 + cr) * 64) * 64;
#pragma unroll
            for (int m = 0; m < 4; ++m) { const int jj = 16 * m + fr; const f32x4 v0 = acc[ai][ai][m][0], v1 = acc[ai][ai][m][1];
                const float v[8] = {v0[0], v0[1], v0[2], v0[3], v1[0], v1[1], v1[2], v1[3]};
                float f[8], r[8];
#pragma unroll
                for (int e = 0; e < 8; ++e) { f[e] = (ss0 + e <= jj) ? v[e] : 0.f; r[7 - e] = (ss0 + e >= jj) ? v[e] : 0.f; }
                u32x4 wf, wr_; wf.x = cvt_pk_bf16(f[0], f[1]); wf.y = cvt_pk_bf16(f[2], f[3]); wf.z = cvt_pk_bf16(f[4], f[5]); wf.w = cvt_pk_bf16(f[6], f[7]);
                wr_.x = cvt_pk_bf16(r[0], r[1]); wr_.y = cvt_pk_bf16(r[2], r[3]); wr_.z = cvt_pk_bf16(r[4], r[5]); wr_.w = cvt_pk_bf16(r[6], r[7]);
                *(u32x4*)(bf + (size_t)jj * 64 + ss0) = wf;
                *(u32x4*)(br + (size_t)(63 - jj) * 64 + (56 - ss0)) = wr_; } }
    }
};
}

__host__ __device__ __forceinline__ int fperm(int col) { const int g = col >> 8, c = col & 255;
    if (c < 128) return (g * 16 + (c >> 3)) * 16 + (c & 7);
    if (c == 128) return (g * 16) * 16 + 8;
    const int m = 256 - c; return (g * 16 + (m >> 3)) * 16 + 8 + (m & 7); }
template <int PERM_MODE = 0>
__device__ __forceinline__ void phase_transpose(LAS unsigned char* lds, const float* W, bf16_t* WT, int K, int N, size_t ldn, int nmat, size_t sW, size_t sWT, int bid, int nb) {
    LAS float* tl = (LAS float*)lds; const int tid = opq_tid();
    const int tk = K / 64, tn = N / 64, ntile = nmat * tk * tn;
    for (int tile = bid; tile < ntile; tile += nb) {
        const int mtx = tile / (tk * tn), rem = tile % (tk * tn), k0 = (rem / tn) * 64, n0 = (rem % tn) * 64;
        { const int r = tid >> 3, c8 = (tid & 7) * 8; const float* src = W + mtx * sW + (size_t)(k0 + r) * ldn + n0 + c8;
          const float4 a = *(const float4*)src, b = *(const float4*)(src + 4);
          __syncthreads();
          LAS float* d = tl + r * 65 + c8; d[0] = a.x; d[1] = a.y; d[2] = a.z; d[3] = a.w; d[4] = b.x; d[5] = b.y; d[6] = b.z; d[7] = b.w; }
        __syncthreads();
        { const int n = tid >> 3, k8 = (tid & 7) * 8; float v[8];
#pragma unroll
          for (int i = 0; i < 8; ++i) v[i] = tl[(k8 + i) * 65 + n];
          if (PERM_MODE == 2) {
#pragma unroll
              for (int i = 0; i < 8; ++i) WT[mtx * sWT + (size_t)(n0 + n) * K + fperm(k0 + k8 + i)] = f2bf(v[i]);
          } else { const int nr = (PERM_MODE == 1) ? fperm(n0 + n) : (n0 + n);
              *(uint4*)(WT + mtx * sWT + (size_t)nr * K + k0 + k8) = make_uint4(pack2(v[0], v[1]), pack2(v[2], v[3]), pack2(v[4], v[5]), pack2(v[6], v[7])); } }
    }
    __syncthreads();
}

struct EpiFold { bf16_t* W;
    __device__ __forceinline__ void operator()(int g, int row, int col, float v) const { const int cc = col & 127, ri = col >> 7; const int r = (g * 16 + (cc >> 3)) * 16 + ri * 8 + (cc & 7); W[(size_t)r * 1024 + row] = f2bf(v); } };
__device__ __forceinline__ void phase_mods(const Params& p, LAS unsigned char* lds) {
    LAS float* sl = (LAS float*)lds; LAS float* red = sl + 9 * 1024; const int tid = opq_tid(), lane = tid & 63, w = tid >> 6;
    for (int i = tid; i < 9 * 1024; i += NTHREADS) { const float v = (i < 8192) ? p.c[i] : p.c_ctx[i - 8192]; sl[i] = silu_f(v); }
    __syncthreads();
    float* mods = (float*)(p.ws + WS_MODS);
    for (int grp = blockIdx.x; grp < 4 * 48; grp += gridDim.x) {
        const int layer = grp / 48, col = (grp % 48) * 64 + lane;
        float acc[9];
#pragma unroll
        for (int v = 0; v < 9; ++v) acc[v] = 0.f;
        const float* wp = p.w_ada + ((size_t)layer * 1024 + w * 128) * 3072 + col;
#pragma unroll 32
        for (int k = 0; k < 128; ++k) { const float wv = wp[(size_t)k * 3072];
#pragma unroll
            for (int v = 0; v < 9; ++v) acc[v] += sl[v * 1024 + w * 128 + k] * wv; }
#pragma unroll
        for (int v = 0; v < 9; ++v) red[(w * 9 + v) * 64 + lane] = acc[v];
        __syncthreads();
        for (int o = tid; o < 9 * 64; o += NTHREADS) { const int v = o >> 6, l = o & 63; float sum = p.b_ada[layer * 3072 + (grp % 48) * 64 + l];
#pragma unroll
            for (int ww = 0; ww < 8; ++ww) sum += red[(ww * 9 + v) * 64 + l];
            mods[((size_t)layer * 9 + v) * 3072 + (grp % 48) * 64 + l] = sum; }
        __syncthreads();
    }
}
__device__ __forceinline__ void phase_tables(const Params& p) {
    float* Fc = (float*)(p.ws + WS_FC);
    const int gt = blockIdx.x * NTHREADS + opq_tid(), gs = gridDim.x * NTHREADS;
    for (int i = gt; i < 256 * 256; i += gs) { const int d = i >> 8, col = i & 255, cc = col & 127; const float a = (float)((d * cc) & 255) * (2.0f / 256.0f);
        float v; if (col < 128) v = cospif(a); else v = (cc == 0) ? ((d & 1) ? -1.0f : 1.0f) : -sinpif(a);
        Fc[i] = v * (1.0f / 16.0f); }
    bf16_t* Tc = (bf16_t*)(p.ws + WS_TCTX);
    for (int i = gt; i < 256 * 256; i += gs) { const int pp = i >> 8, n = i & 255; const float a = (float)((pp * n) & 255) * (2.0f / 256.0f);
        Tc[i] = f2bf(cospif(a) * (1.0f / 16.0f)); Tc[65536 + i] = f2bf(sinpif(a) * (1.0f / 16.0f)); }
}
__device__ __forceinline__ void conv_unpack(const uint4 xv, float (&x)[8]) {
    x[0] = __uint_as_float(xv.x << 16); x[1] = __uint_as_float(xv.x & 0xffff0000u); x[2] = __uint_as_float(xv.y << 16); x[3] = __uint_as_float(xv.y & 0xffff0000u);
    x[4] = __uint_as_float(xv.z << 16); x[5] = __uint_as_float(xv.z & 0xffff0000u); x[6] = __uint_as_float(xv.w << 16); x[7] = __uint_as_float(xv.w & 0xffff0000u);
}
__device__ __forceinline__ void phase_hmod(const Params& p, int layer, int b0, int tlat, int nrows, bf16_t* H, int bid, int nb) {
    const float* mods = (const float*)(p.ws + WS_MODS) + (size_t)layer * 9 * 3072; const float* ng = p.norm_g + layer * D;
    const bf16_t* xlb = (const bf16_t*)p.out; const bf16_t* xcb = (const bf16_t*)(p.ws + WS_XC);
    const int tid = opq_tid(), lane = tid & 63, gw = bid * 8 + (tid >> 6), nw = nb * 8;
    for (int r = gw; r < nrows; r += nw) {
        size_t gi; const float* mv; bool lat = r < tlat;
        if (lat) { const int b = b0 + (r >> 12); gi = (size_t)b * SEQ + (r & 4095); mv = mods + (size_t)b * 3072; }
        else { const int rc = r - tlat; const int b = b0 + (rc >> 8); gi = (size_t)b * CTX + (rc & 255); mv = mods + (size_t)8 * 3072; }
        float v[2][8]; float ss = 0.f;
        if (layer == 0) { const float* src = (lat ? p.x : p.ctx) + gi * D;
#pragma unroll
            for (int i = 0; i < 2; ++i) { const float4 a = *(const float4*)(src + i * 512 + lane * 8), b = *(const float4*)(src + i * 512 + lane * 8 + 4);
                v[i][0] = a.x; v[i][1] = a.y; v[i][2] = a.z; v[i][3] = a.w; v[i][4] = b.x; v[i][5] = b.y; v[i][6] = b.z; v[i][7] = b.w; }
        } else { const bf16_t* src = lat ? (xlb + gi * (2 * D)) : (xcb + gi * D);
#pragma unroll
            for (int i = 0; i < 2; ++i) { const uint4 a = *(const uint4*)(src + i * 512 + lane * 8); conv_unpack(a, v[i]); }
        }
#pragma unroll
        for (int i = 0; i < 2; ++i)
#pragma unroll
            for (int e = 0; e < 8; ++e) ss += v[i][e] * v[i][e];
        ss = wave_sum(ss);
        const float rs = rsqrtf(ss * (1.0f / D) + EPS);
#pragma unroll
        for (int i = 0; i < 2; ++i) { const int c0 = i * 512 + lane * 8; float o[8];
#pragma unroll
            for (int h = 0; h < 2; ++h) { const float4 g = *(const float4*)(ng + c0 + 4 * h), sh = *(const float4*)(mv + c0 + 4 * h), sc = *(const float4*)(mv + 1024 + c0 + 4 * h);
                o[4 * h + 0] = v[i][4 * h + 0] * rs * g.x * (1.f + sc.x) + sh.x; o[4 * h + 1] = v[i][4 * h + 1] * rs * g.y * (1.f + sc.y) + sh.y;
                o[4 * h + 2] = v[i][4 * h + 2] * rs * g.z * (1.f + sc.z) + sh.z; o[4 * h + 3] = v[i][4 * h + 3] * rs * g.w * (1.f + sc.w) + sh.w; }
            *(uint4*)(H + (size_t)r * D + c0) = make_uint4(pack2(o[0], o[1]), pack2(o[2], o[3]), pack2(o[4], o[5]), pack2(o[6], o[7])); }
    }
}
__device__ __forceinline__ void phase_conv(const Params& p, int j, const bf16_t* XM, bf16_t* XCV) {
    const float* cw = p.m_conv_w + (size_t)j * 9 * E; const float* cb = p.m_conv_b + (size_t)j * E;
    const int gt = blockIdx.x * NTHREADS + opq_tid(), gs = gridDim.x * NTHREADS;
    constexpr int NLAT = HB * 64 * 8 * 256, NCTX = HB * 32 * 256;
    float bs[8];
    { const int c8 = (gt & 255) * 8; const float4 b0 = *(const float4*)(cb + c8), b1 = *(const float4*)(cb + c8 + 4);
      bs[0] = b0.x; bs[1] = b0.y; bs[2] = b0.z; bs[3] = b0.w; bs[4] = b1.x; bs[5] = b1.y; bs[6] = b1.z; bs[7] = b1.w; }
    for (int i = gt; i < NLAT + NCTX; i += gs) {
        const bool isl = i < NLAT; const int ii = isl ? i : i - NLAT;
        const int c8 = (ii & 255) * 8, strip = ii >> 8;
        int tok0, ncol, c0, krows, r;
        if (isl) { const int cs = strip & 7, rr = (strip >> 3) & 63, bl = strip >> 9; tok0 = bl * SEQ + rr * 64; ncol = 64; c0 = cs * 8; krows = 3; r = rr; }
        else { const int cs = strip & 31, bl = strip >> 5; tok0 = TLAT + bl * CTX; ncol = 256; c0 = cs * 8; krows = 1; r = 0; }
        float acc[8][8];
#pragma unroll
        for (int o = 0; o < 8; ++o)
#pragma unroll
            for (int e = 0; e < 8; ++e) acc[o][e] = bs[e];
#pragma unroll
        for (int kh = 0; kh < 3; ++kh) {
            if (krows == 1 && kh != 1) continue;
            const int rr = r + kh - 1; if (isl && (rr < 0 || rr > 63)) continue;
            const bf16_t* rowp = XM + ((size_t)tok0 + (isl ? (kh - 1) * 64 : 0)) * E + c8;
            float4 wq[3][2];
#pragma unroll
            for (int kw = 0; kw < 3; ++kw) { const float* wp = cw + (size_t)(kh * 3 + kw) * E + c8; wq[kw][0] = *(const float4*)wp; wq[kw][1] = *(const float4*)(wp + 4); }
            uint4 xr[10];
#pragma unroll
            for (int cc = 0; cc < 10; ++cc) { int col = c0 - 1 + cc; col = col < 0 ? 0 : (col >= ncol ? ncol - 1 : col); xr[cc] = *(const uint4*)(rowp + (size_t)col * E); }
            if (c0 == 0) xr[0] = make_uint4(0u, 0u, 0u, 0u);
            if (c0 + 8 >= ncol) xr[9] = make_uint4(0u, 0u, 0u, 0u);
#pragma unroll
            for (int cc = 0; cc < 10; ++cc) {
                float x[8]; conv_unpack(xr[cc], x);
#pragma unroll
                for (int kw = 0; kw < 3; ++kw) { const int o = cc - kw; if (o < 0 || o > 7) continue;
#pragma unroll
                    for (int e = 0; e < 8; ++e) acc[o][e] += x[e] * ((e < 4) ? wq[kw][0] : wq[kw][1])[e & 3]; }
            }
        }
#pragma unroll
        for (int o = 0; o < 8; ++o)
            *(uint4*)(XCV + ((size_t)tok0 + c0 + o) * E + c8) = make_uint4(pack2(silu_f(acc[o][0]), silu_f(acc[o][1])), pack2(silu_f(acc[o][2]), silu_f(acc[o][3])), pack2(silu_f(acc[o][4]), silu_f(acc[o][5])), pack2(silu_f(acc[o][6]), silu_f(acc[o][7])));
    }
}

__device__ __forceinline__ void phase_gfold(const Params& p, int j, bf16_t* WgT, int bid, int nb) {
    const int tid = opq_tid(), lane = tid & 63, gw = bid * 8 + (tid >> 6), nw = nb * 8;
    const float* wif = p.m_w_if + (size_t)j * 2 * 3 * E * 8;
    for (int i = gw; i < 2 * E * 2; i += nw) {
        const int k = i >> 1, r = i & 1;
        float acc[8];
#pragma unroll
        for (int g = 0; g < 8; ++g) acc[g] = 0.f;
        if (k < E) {
            const int h = k >> 9;
            const float* wq = p.m_w_q + ((size_t)j * NH * DH + k) * DH; const float* wk = p.m_w_k + ((size_t)j * NH * DH + k) * DH;
            const float* gq = wif + (((size_t)r * 3 + 0) * E + h * DH) * 8; const float* gk = wif + (((size_t)r * 3 + 1) * E + h * DH) * 8;
#pragma unroll
            for (int t = 0; t < 8; ++t) { const int e = t * 64 + lane; const float a = wq[e], b = wk[e] * 0.044194173824159216f;
                const float4 q0 = *(const float4*)(gq + e * 8), q1 = *(const float4*)(gq + e * 8 + 4), k0 = *(const float4*)(gk + e * 8), k1 = *(const float4*)(gk + e * 8 + 4);
                acc[0] += a * q0.x + b * k0.x; acc[1] += a * q0.y + b * k0.y; acc[2] += a * q0.z + b * k0.z; acc[3] += a * q0.w + b * k0.w;
                acc[4] += a * q1.x + b * k1.x; acc[5] += a * q1.y + b * k1.y; acc[6] += a * q1.z + b * k1.z; acc[7] += a * q1.w + b * k1.w; }
#pragma unroll
            for (int g = 0; g < 8; ++g) acc[g] = wave_sum(acc[g]);
        } else {
            const float* gv = wif + (((size_t)r * 3 + 2) * E + (k - E)) * 8;
#pragma unroll
            for (int g = 0; g < 8; ++g) acc[g] = gv[g];
        }
        if (lane < 8) { float v = acc[0];
#pragma unroll
            for (int g = 1; g < 8; ++g) v = (lane == g) ? acc[g] : v;
            WgT[(size_t)(r * 8 + lane) * 4096 + k] = f2bf(v); }
    }
}
constexpr int GROW = 8208;
__device__ __forceinline__ void phase_gates(LAS unsigned char* lds, const bf16_t* XCV, const bf16_t* XM, const bf16_t* WgT, float* LI, float* LF, const float* b_i, const float* b_f) {
    const int tid = opq_tid(), lane = tid & 63, w = tid >> 6, fr = lane & 15, fq = lane >> 4, tsel = w & 3, khalf = w >> 2;
    __syncthreads();
    for (int i = tid; i < 16 * 512; i += NTHREADS) { const int c = i >> 9, k16 = i & 511; const uint4 v = *(const uint4*)(WgT + (size_t)c * 4096 + k16 * 8);
        *(LAS u32x4*)(lds + c * GROW + k16 * 16) = (u32x4){v.x, v.y, v.z, v.w}; }
    __syncthreads();
    LAS float* red = (LAS float*)(lds + 16 * GROW);
    const bf16_t* Asrc = khalf ? XM : XCV;
    for (int grp = blockIdx.x; grp < TH / 64; grp += gridDim.x) {
        const int tok0 = grp * 64 + tsel * 16;
        f32x4 acc = (f32x4){0.f, 0.f, 0.f, 0.f};
        const bf16_t* ap = Asrc + (size_t)(tok0 + fr) * E + fq * 8;
        LAS unsigned char* bp = lds + fr * GROW + (khalf * 2048 + fq * 8) * 2;
#pragma unroll 8
        for (int u = 0; u < 64; ++u) {
            const uint4 av = *(const uint4*)(ap + u * 32);
            union { bf16x8 v; unsigned wd[4]; } a_; a_.wd[0] = av.x; a_.wd[1] = av.y; a_.wd[2] = av.z; a_.wd[3] = av.w;
            const bf16x8 b = *(const LAS bf16x8*)(bp + u * 64);
            acc = __builtin_amdgcn_mfma_f32_16x16x32_bf16(a_.v, b, acc, 0, 0, 0);
        }
        if (khalf) *(LAS f32x4*)(red + (tsel * 64 + lane) * 4) = acc;
        __syncthreads();
        if (!khalf) {
            const f32x4 o = acc + *(const LAS f32x4*)(red + (tsel * 64 + lane) * 4);
            const int r = fr >> 3, g8 = fr & 7;
#pragma unroll
            for (int q = 0; q < 4; ++q) { const int tok = tok0 + 4 * fq + q;
                if (g8 < 4) LI[((size_t)r * TH + tok) * 4 + g8] = o[q] + b_i[r * 4 + g8];
                else { const int hh = g8 - 4; const float xx = o[q] + b_f[r * 4 + hh]; LF[((size_t)r * TH + tok) * 4 + hh] = fminf(xx, 0.f) - log1pf(__expf(-fabsf(xx))); } }
        }
        __syncthreads();
    }
}

__device__ __forceinline__ int scan_tok(int c, int jj, int dir, int bl) {
    if (c < 4) { int pos = 64 * c + jj; if (dir) pos = CTX - 1 - pos; return TLAT + bl * CTX + pos; }
    int pos = 64 * (c - 4) + jj; if (dir) pos = SEQ - 1 - pos; return bl * SEQ + pos;
}
#define SCAN_BAR() do { asm volatile("s_waitcnt lgkmcnt(0)" ::: "memory"); __builtin_amdgcn_s_barrier(); asm volatile("" ::: "memory"); } while (0)
__device__ __forceinline__ unsigned swap16(unsigned x) { return __builtin_amdgcn_alignbit(x, x, 16); }
__device__ __forceinline__ void phase_scan(LAS unsigned char* lds, const bf16_t* Q, const bf16_t* K, const bf16_t* V, const bf16_t* Sraw, const float* LI, const float* LF, bf16_t* Hf, bf16_t* Hr) {
    const int tid = opq_tid(), lane0 = tid & 63, w = __builtin_amdgcn_readfirstlane(tid >> 6), vg = w & 3, kh = w >> 2;
#define SCAN_OPQ int lane = lane0; asm volatile("" : "+v"(lane)); const int fr = lane & 15, fq = lane >> 4;
    LAS unsigned char* Qs = lds + L_QS; LAS unsigned char* Ks = lds + L_KS;
    LAS float* sArr = (LAS float*)(lds + L_SARR); LAS float* sDenB = (LAS float*)(lds + L_SDEN);
    LAS unsigned char* Vs = lds + L_VS; LAS unsigned char* xch = lds + L_XCH; LAS float* sDecay = sDenB + 576; LAS float* rowrec = (LAS float*)(lds + L_ROWREC);
    for (int unit = blockIdx.x; unit < 256; unit += gridDim.x) {
        const int xcd = unit & 7, ix = unit >> 3, stream = xcd * 4 + (ix >> 3), vs = ix & 7;
        const int dir = stream & 1, bl = (stream >> 1) & 3, h = stream >> 3;
        const int vcol0 = h * DH + vs * 64 + vg * 16, hq = h * DH;
        bf16_t* H = dir ? Hr : Hf;
        const bf16_t* Qh = Q + hq; const bf16_t* Kh = K + hq;
        const bf16_t* Sb = Sraw + (size_t)dir * HB * NH * 68 * 4096 + (size_t)(bl * NH + h) * 68 * 4096;
        f32x4 X[16];
#pragma unroll
        for (int t = 0; t < 16; ++t) X[t] = (f32x4){0.f, 0.f, 0.f, 0.f};
        f32x4 nX[4];
#pragma unroll
        for (int t = 0; t < 4; ++t) nX[t] = (f32x4){0.f, 0.f, 0.f, 0.f};
        float m_cur = 0.f, Pcur = 1.0f;
        u32x4 sf[2][2];
        __syncthreads();
        { SCAN_OPQ
#pragma unroll
          for (int i = 0; i < 8; ++i) { const int row = w * 8 + i; const size_t t = (size_t)scan_tok(0, row, dir, bl);
              __builtin_amdgcn_global_load_lds((const unsigned*)(Qh + t * E + lane * 8), (LAS unsigned*)(Qs + row * QROW), 16, 0, 0);
              __builtin_amdgcn_global_load_lds((const unsigned*)(Kh + t * E + lane * 8), (LAS unsigned*)(Ks + row * KROW), 16, 0, 0); }
          __builtin_amdgcn_global_load_lds((const unsigned*)(V + (size_t)scan_tok(0, w * 8 + (lane >> 3), dir, bl) * E + h * DH + vs * 64 + (lane & 7) * 8), (LAS unsigned*)(Vs + w * 1024), 16, 0, 0);
#pragma unroll
          for (int q = 0; q < 2; ++q)
#pragma unroll
              for (int st = 0; st < 2; ++st) { const uint4 v_ = *(const uint4*)(Sb + (size_t)(16 * (2 * kh + q) + fr) * 64 + 32 * st + 8 * fq); sf[q][st] = (u32x4){v_.x, v_.y, v_.z, v_.w}; }
        }
        const int stp = dir ? -1 : 1;
#define SCAN_TOK0(cc) (((cc) < 4) ? (TLAT + bl * CTX + (dir ? CTX - 1 - 64 * (cc) : 64 * (cc))) : (bl * SEQ + (dir ? SEQ - 1 - 64 * ((cc) - 4) : 64 * ((cc) - 4))))
        float li_n = 0.f, lf_n = 0.f;
        if (w == 7) { const size_t t = (size_t)scan_tok(0, lane0, dir, bl); li_n = LI[((size_t)dir * TH + t) * 4 + h]; lf_n = LF[((size_t)dir * TH + t) * 4 + h]; }
        for (int c = 0; c < 68; ++c) {
            const int pb = c & 1;
            LAS float* sWp = sArr + pb * 320; LAS float* sWs = sWp + 64; LAS float* sEmn = sWp + 128; LAS float* sEm = sWp + 192;
            if (c == 0) {
                if (w == 7) { SCAN_OPQ
                    const float bc = wave_scan_sum(lf_n); const float g = li_n - bc; const float rm = wave_scan_max(g);
                    const float Mj = fmaxf(m_cur, rm); const float M63 = __shfl(Mj, 63), b63 = __shfl(bc, 63);
                    const float dec = fmaxf(__expf(m_cur - M63), 1.0e-9f); float rn = 1.0f; if (Pcur < 1.0e-9f) { rn = Pcur; Pcur = 1.0f; }
                    const float Pn = Pcur * dec, iPn = 1.0f / Pn;
                    sWp[lane] = __expf(m_cur - Mj) * Pcur; sWs[lane] = __expf(g - M63) * iPn; sEmn[lane] = __expf(-(bc + Mj)); sEm[lane] = __expf(M63 - Mj) * Pn;
                    if (lane == 0) sDecay[pb] = rn;
                    m_cur = b63 + M63; Pcur = Pn;
                }
                asm volatile("s_waitcnt vmcnt(0)" ::: "memory");
                SCAN_BAR();
            }
            const bool more = (c + 1 < 68);
            bf16x8 vf[2]; u32x4 sfn[2][2];
            { SCAN_OPQ
#pragma unroll
              for (int st = 0; st < 2; ++st) { union { bf16x8 v; s16x4 h4[2]; } u_;
#pragma unroll
                  for (int hh = 0; hh < 2; ++hh) u_.h4[hh] = __builtin_amdgcn_ds_read_tr16_b64_v4i16((LAS s16x4*)(Vs + (32 * st + 8 * fq + 4 * hh + (fr >> 2)) * 128 + (vg * 16 + 4 * (fr & 3)) * 2));
                  vf[st] = u_.v; }
              if (more && w == 7) { const size_t t = (size_t)(SCAN_TOK0(c + 1) + stp * lane); li_n = LI[((size_t)dir * TH + t) * 4 + h]; lf_n = LF[((size_t)dir * TH + t) * 4 + h]; }
              if (more) {
#pragma unroll
                  for (int q = 0; q < 2; ++q)
#pragma unroll
                      for (int st = 0; st < 2; ++st) { const uint4 v_ = *(const uint4*)(Sb + ((size_t)(c + 1) * 64 + 16 * (2 * kh + q) + fr) * 64 + 32 * st + 8 * fq); sfn[q][st] = (u32x4){v_.x, v_.y, v_.z, v_.w}; }
              } else {
#pragma unroll
                  for (int q = 0; q < 2; ++q)
#pragma unroll
                      for (int st = 0; st < 2; ++st) sfn[q][st] = sf[q][st];
              }
            }
            { const float rn = sDecay[pb];
              if (rn != 1.0f) {
#pragma unroll
                  for (int t = 0; t < 16; ++t) X[t] = X[t] * rn;
#pragma unroll
                  for (int t = 0; t < 4; ++t) nX[t] = nX[t] * rn; } }
            f32x4 o[4];
            { SCAN_OPQ
            f32x4 qn[4];
#pragma unroll
            for (int jj = 0; jj < 4; ++jj) { o[jj] = (f32x4){0.f, 0.f, 0.f, 0.f}; qn[jj] = (f32x4){0.f, 0.f, 0.f, 0.f}; }
            bf16x8 af[2][4];
            { const int kb0 = kh * 256 + 32 * ((0 + 2 * vg) & 7);
#pragma unroll
              for (int jj = 0; jj < 4; ++jj) af[0][jj] = *(const LAS bf16x8*)(Qs + ((((jj + 2 * kh) & 3) * 16 + fr) * QROW) + (kb0 + 8 * fq) * 2); }
#pragma unroll
            for (int u = 0; u < 8; ++u) {
                if (u + 1 < 8) { const int kb1 = kh * 256 + 32 * ((u + 1 + 2 * vg) & 7);
#pragma unroll
                    for (int jj = 0; jj < 4; ++jj) af[(u + 1) & 1][jj] = *(const LAS bf16x8*)(Qs + ((((jj + 2 * kh) & 3) * 16 + fr) * QROW) + (kb1 + 8 * fq) * 2); }
                union { bf16x8 v; unsigned wd[4]; } bfr;
                bfr.wd[0] = pack2(X[2 * u][0], X[2 * u][1]); bfr.wd[1] = pack2(X[2 * u][2], X[2 * u][3]);
                bfr.wd[2] = pack2(X[2 * u + 1][0], X[2 * u + 1][1]); bfr.wd[3] = pack2(X[2 * u + 1][2], X[2 * u + 1][3]);
                union { bf16x8 v; unsigned wd[4]; } nfr;
                if (u < 2) { nfr.wd[0] = pack2(nX[2 * u][0], nX[2 * u][1]); nfr.wd[1] = pack2(nX[2 * u][2], nX[2 * u][3]);
                    nfr.wd[2] = pack2(nX[2 * u + 1][0], nX[2 * u + 1][1]); nfr.wd[3] = pack2(nX[2 * u + 1][2], nX[2 * u + 1][3]); }
                __builtin_amdgcn_sched_barrier(0);
#pragma unroll
                for (int jj = 0; jj < 4; ++jj) {
                    o[jj] = __builtin_amdgcn_mfma_f32_16x16x32_bf16(af[u & 1][jj], bfr.v, o[jj], 0, 0, 0);
                    if (u < 2) qn[jj] = __builtin_amdgcn_mfma_f32_16x16x32_bf16(af[u & 1][jj], nfr.v, qn[jj], 0, 0, 0);
                }
                __builtin_amdgcn_sched_barrier(0);
            }
            if (fr == 0) {
#pragma unroll
                for (int jj = 0; jj < 4; ++jj)
#pragma unroll
                    for (int r = 0; r < 4; ++r) sDenB[w * 64 + ((jj + 2 * kh) & 3) * 16 + 4 * fq + r] = qn[jj][r];
            }
            }
            SCAN_BAR();
            if (more) { SCAN_OPQ
                const int tb = SCAN_TOK0(c + 1);
                const bf16_t* qrow = Qh + (ptrdiff_t)(tb + stp * (w * 8)) * E + lane * 8; const ptrdiff_t rstep = (ptrdiff_t)stp * E;
#pragma unroll
                for (int i = 0; i < 8; ++i) __builtin_amdgcn_global_load_lds((const unsigned*)(qrow + i * rstep), (LAS unsigned*)(Qs + (w * 8 + i) * QROW), 16, 0, 0);
            }
            bf16x8 wv[2], wsf[2];
            { SCAN_OPQ
#pragma unroll
                for (int st = 0; st < 2; ++st) { const f32x4 a0 = *(const LAS f32x4*)(sWs + 32 * st + 8 * fq), a1 = *(const LAS f32x4*)(sWs + 32 * st + 8 * fq + 4);
                    union { bf16x8 v; unsigned wd[4]; } t_; t_.wd[0] = pack2(a0[0], a0[1]); t_.wd[1] = pack2(a0[2], a0[3]); t_.wd[2] = pack2(a1[0], a1[1]); t_.wd[3] = pack2(a1[2], a1[3]); wsf[st] = t_.v;
                    union { bf16x8 v; unsigned wd[4]; } vv, ww; vv.v = vf[st];
                    ww.wd[0] = pack2(__uint_as_float(vv.wd[0] << 16) * a0[0], __uint_as_float(vv.wd[0] & 0xffff0000u) * a0[1]); ww.wd[1] = pack2(__uint_as_float(vv.wd[1] << 16) * a0[2], __uint_as_float(vv.wd[1] & 0xffff0000u) * a0[3]);
                    ww.wd[2] = pack2(__uint_as_float(vv.wd[2] << 16) * a1[0], __uint_as_float(vv.wd[2] & 0xffff0000u) * a1[1]); ww.wd[3] = pack2(__uint_as_float(vv.wd[3] << 16) * a1[2], __uint_as_float(vv.wd[3] & 0xffff0000u) * a1[3]);
                    wv[st] = ww.v; }
                bf16x8 kf[2][2][2];
#define SCAN_KT(dst, T_) do { const int kc_ = kh * 256 + 32 * ((((T_) >> 1) + 2 * vg) & 7) + 8 * (fr & 3) + 4 * ((T_) & 1); \
        _Pragma("unroll") for (int st = 0; st < 2; ++st) { union { bf16x8 v; s16x4 h4[2]; } a_; \
            _Pragma("unroll") for (int hh = 0; hh < 2; ++hh) a_.h4[hh] = __builtin_amdgcn_ds_read_tr16_b64_v4i16((LAS s16x4*)(Ks + (32 * st + 8 * fq + 4 * hh + (fr >> 2)) * KROW + kc_ * 2)); \
            dst[st] = a_.v; } } while (0)
                SCAN_KT(kf[0][0], 0); SCAN_KT(kf[0][1], 1);
#pragma unroll
                for (int P = 0; P < 8; ++P) {
                    if (P + 1 < 8) { SCAN_KT(kf[(P + 1) & 1][0], 2 * P + 2); SCAN_KT(kf[(P + 1) & 1][1], 2 * P + 3); }
                    __builtin_amdgcn_sched_barrier(0);
#pragma unroll
                    for (int tp = 0; tp < 2; ++tp)
#pragma unroll
                        for (int st = 0; st < 2; ++st) { const int T = 2 * P + tp;
                            X[T] = __builtin_amdgcn_mfma_f32_16x16x32_bf16(kf[P & 1][tp][st], wv[st], X[T], 0, 0, 0);
                            if (T < 4) nX[T & 3] = __builtin_amdgcn_mfma_f32_16x16x32_bf16(kf[P & 1][tp][st], wsf[st], nX[T & 3], 0, 0, 0); }
                    __builtin_amdgcn_sched_barrier(0);
                }
#undef SCAN_KT
            }
            SCAN_BAR();
            if (more) {
                { SCAN_OPQ
                  const int tb = SCAN_TOK0(c + 1);
                  const bf16_t* krow = Kh + (ptrdiff_t)(tb + stp * (w * 8)) * E + lane * 8;
                  const ptrdiff_t rstep = (ptrdiff_t)stp * E;
#pragma unroll
                  for (int i = 0; i < 8; ++i) __builtin_amdgcn_global_load_lds((const unsigned*)(krow + i * rstep), (LAS unsigned*)(Ks + (w * 8 + i) * KROW), 16, 0, 0);
                  __builtin_amdgcn_global_load_lds((const unsigned*)(V + (ptrdiff_t)(tb + stp * (w * 8 + (lane >> 3))) * E + h * DH + vs * 64 + (lane & 7) * 8), (LAS unsigned*)(Vs + w * 1024), 16, 0, 0);
                }
            }
            if (more && w == 7) { SCAN_OPQ
                LAS float* nG = sArr + (pb ^ 1) * 320;
                const float bc = wave_scan_sum(lf_n); const float g = li_n - bc; const float rm = wave_scan_max(g);
                const float Mj = fmaxf(m_cur, rm); const float M63 = __shfl(Mj, 63), b63 = __shfl(bc, 63);
                const float dec = fmaxf(__expf(m_cur - M63), 1.0e-9f); float rn = 1.0f; if (Pcur < 1.0e-9f) { rn = Pcur; Pcur = 1.0f; }
                const float Pn = Pcur * dec, iPn = 1.0f / Pn;
                nG[lane] = __expf(m_cur - Mj) * Pcur; nG[64 + lane] = __expf(g - M63) * iPn; nG[128 + lane] = __expf(-(bc + Mj)); nG[192 + lane] = __expf(M63 - Mj) * Pn;
                if (lane == 0) sDecay[pb ^ 1] = rn;
                m_cur = b63 + M63; Pcur = Pn;
            }
            if (tid < 64) { float sq = 0.f;
#pragma unroll
                for (int ww = 0; ww < 8; ++ww) sq += sDenB[ww * 64 + tid];
                const float wp_ = sWp[tid];
                *(LAS f32x4*)(rowrec + tid * 4) = (f32x4){wp_, sEm[tid], sEmn[tid], wp_ * sq}; }
            { SCAN_OPQ
#pragma unroll
                for (int q = 0; q < 2; ++q) { const f32x4 ov = o[2 + q];
                    *(LAS u32x2*)(xch + w * 1024 + ((q * 4 + fq) * 16 + fr) * 8) = (u32x2){pack2(ov[0], ov[1]), pack2(ov[2], ov[3])}; }
            }
            SCAN_BAR();
            { SCAN_OPQ
                const int partner = vg + 4 * (1 - kh); const int vcol = vcol0 + fr;
                bf16_t* hrow = H + (ptrdiff_t)(SCAN_TOK0(c) + stp * (2 * kh * 16 + 4 * fq)) * E + vcol; const ptrdiff_t hstep = (ptrdiff_t)stp * E;
                u32x2 pw[2]; f32x4 rec[2][4];
#pragma unroll
                for (int q = 0; q < 2; ++q) { pw[q] = *(const LAS u32x2*)(xch + partner * 1024 + ((q * 4 + fq) * 16 + fr) * 8);
#pragma unroll
                    for (int r = 0; r < 4; ++r) rec[q][r] = *(const LAS f32x4*)(rowrec + ((2 * kh + q) * 16 + 4 * fq + r) * 4); }
                __builtin_amdgcn_sched_barrier(0);
                f32x4 pvv[2], dsum[2];
#pragma unroll
                for (int q = 0; q < 2; ++q) { pvv[q] = (f32x4){0.f, 0.f, 0.f, 0.f}; dsum[q] = (f32x4){0.f, 0.f, 0.f, 0.f};
#pragma unroll
                    for (int st = 0; st < 2; ++st) { union { bf16x8 v; u32x4 w4; } a_; a_.w4 = sf[q][st];
                        pvv[q] = __builtin_amdgcn_mfma_f32_16x16x32_bf16(a_.v, wv[st], pvv[q], 0, 0, 0);
                        dsum[q] = __builtin_amdgcn_mfma_f32_16x16x32_bf16(a_.v, wsf[st], dsum[q], 0, 0, 0); } }
#pragma unroll
                for (int q = 0; q < 2; ++q) {
                    const int jt = 2 * kh + q;
                    const float pv_[4] = {__uint_as_float(pw[q].x << 16), __uint_as_float(pw[q].x & 0xffff0000u), __uint_as_float(pw[q].y << 16), __uint_as_float(pw[q].y & 0xffff0000u)};
#pragma unroll
                    for (int r = 0; r < 4; ++r) { const int j = jt * 16 + 4 * fq + r; const f32x4 rc = rec[q][r];
                        const float num = (o[q][r] + pv_[r]) * rc[0] + rc[1] * pvv[q][r], den = rc[3] + rc[1] * dsum[q][r];
                        const float dn = fmaxf(fabsf(den), rc[2]);
                        hrow[(q * 16 + r) * hstep] = f2bf(num * __builtin_amdgcn_rcpf(dn)); }
                }
            }
#pragma unroll
            for (int q = 0; q < 2; ++q)
#pragma unroll
                for (int st = 0; st < 2; ++st) sf[q][st] = sfn[q][st];
            asm volatile("s_waitcnt vmcnt(8)" ::: "memory");
            SCAN_BAR();
        }
    }
    __syncthreads();
}
#undef SCAN_TOK0
#undef SCAN_OPQ
#undef SCAN_BAR

constexpr int YZW = 4096;
__device__ __forceinline__ int fplane_off(int n2, int n1) { return n2 * 128 + ((((n1 >> 3) ^ (n2 & 7))) << 4) + (n1 & 7) * 2; }
__device__ __forceinline__ void phase_fft(LAS unsigned char* lds, const bf16_t* YZ, bf16_t* Yout, int nbat) {
    const int tid0 = opq_tid(), w = tid0 >> 6, pt = w & 3, chalf = w >> 2;
#define FFT_OPQ int tid = tid0; asm volatile("" : "+v"(tid)); const int lane = tid & 63, fr = lane & 15, fq = lane >> 4;
    const int lane = tid0 & 63, fr = lane & 15, fq = lane >> 4;
    bf16x8 Cm[2], Sm[2], nSm[2];
#pragma unroll
    for (int ks = 0; ks < 2; ++ks)
#pragma unroll
        for (int jj = 0; jj < 8; ++jj) { const int n1 = 32 * ks + 8 * fq + jj, p1 = 16 * pt + fr; const float a = (float)((n1 * p1) & 63) * (2.0f / 64.0f);
            const float cv = cospif(a) * 0.125f, sv = sinpif(a) * 0.125f; Cm[ks][jj] = (short)f2bf(cv); Sm[ks][jj] = (short)f2bf(sv); nSm[ks][jj] = (short)f2bf(-sv); }
    float twc[4][4], tws[4][4];
#pragma unroll
    for (int nt = 0; nt < 4; ++nt)
#pragma unroll
        for (int r = 0; r < 4; ++r) { const int n2 = 16 * nt + 4 * fq + r, p1 = 16 * pt + fr; const float a = (float)(n2 * p1) * (2.0f / 4096.0f); twc[nt][r] = cospif(a); tws[nt][r] = sinpif(a); }
    LAS unsigned char* G2 = lds + 131072;
    __syncthreads();
#pragma unroll
    for (int q = 0; q < 2; ++q) { const int idx = 2 * w + q, p2t = idx >> 2, ks = (idx >> 1) & 1, sn = idx & 1; bf16x8 g;
#pragma unroll
        for (int jj = 0; jj < 8; ++jj) { const int n2 = 32 * ks + ((jj < 4) ? (4 * fq + jj) : (16 + 4 * fq + jj - 4)), p2 = 16 * p2t + fr; const float a = (float)((n2 * p2) & 63) * (2.0f / 64.0f);
            g[jj] = (short)f2bf((sn ? sinpif(a) : cospif(a)) * 0.125f); }
        *(LAS bf16x8*)(G2 + idx * 1024 + lane * 16) = g; }
    for (int slab = blockIdx.x; slab < nbat * 128; slab += gridDim.x) {
        const int bl = slab >> 7, id = slab & 127, sl = (id & 7) * 16 + (id >> 3);
        const bool special = (sl & 15) == 0;
        const bf16_t* src = YZ + (size_t)bl * SEQ * YZW + sl * 16;
        __syncthreads();
#pragma unroll
        for (int hb = 0; hb < 2; ++hb) { FFT_OPQ
            uint4 vr[4], vi[4];
#pragma unroll
            for (int q = 0; q < 4; ++q) { const int it = hb * 4 + q, n1 = (it << 3) | (lane >> 3), n2 = (w << 3) | (lane & 7);
                const bf16_t* gp = src + (size_t)(64 * n1 + n2) * YZW; vr[q] = *(const uint4*)gp; vi[q] = *(const uint4*)(gp + 8); }
#pragma unroll
            for (int q = 0; q < 4; ++q) { const int it = hb * 4 + q, n1 = (it << 3) | (lane >> 3), n2 = (w << 3) | (lane & 7);
                LAS unsigned char* d = lds + fplane_off(n2, n1);
                const unsigned wr_[4] = {vr[q].x, vr[q].y, vr[q].z, vr[q].w}, wi_[4] = {vi[q].x, vi[q].y, vi[q].z, vi[q].w};
#pragma unroll
                for (int c = 0; c < 8; ++c) { *(LAS bf16_t*)(d + c * 8192) = (bf16_t)((c & 1) ? (wr_[c >> 1] >> 16) : (wr_[c >> 1] & 0xffffu));
                    *(LAS bf16_t*)(d + (8 + c) * 8192) = (bf16_t)((c & 1) ? (wi_[c >> 1] >> 16) : (wi_[c >> 1] & 0xffffu)); } }
            asm volatile("" ::: "memory");
        }
        __syncthreads();
        uint4 zv[8][2];
        { const int tidz = tid0;
#pragma unroll
          for (int i = 0; i < 8; ++i) { const bf16_t* zp = YZ + ((size_t)bl * SEQ + tidz + NTHREADS * i) * YZW + 2048 + sl * 16; zv[i][0] = *(const uint4*)zp; zv[i][1] = *(const uint4*)(zp + 8); } }
        for (int ci = 0; ci < 4; ++ci) { FFT_OPQ
            const int c = 4 * chalf + ci;
            const bool want_im = special && (c == 0);
            LAS unsigned char* Pr = lds + c * 8192; LAS unsigned char* Pi = lds + (8 + c) * 8192;
            f32x4 Xr[4], Xi[4];
#pragma unroll
            for (int nt = 0; nt < 4; ++nt) {
                f32x4 xr = (f32x4){0.f, 0.f, 0.f, 0.f}, xi = (f32x4){0.f, 0.f, 0.f, 0.f};
                const int n2 = 16 * nt + fr;
#pragma unroll
                for (int ks = 0; ks < 2; ++ks) { const int off = n2 * 128 + (((4 * ks + fq) ^ (n2 & 7)) << 4);
                    const bf16x8 yr = *(const LAS bf16x8*)(Pr + off), yi = *(const LAS bf16x8*)(Pi + off);
                    xr = __builtin_amdgcn_mfma_f32_16x16x32_bf16(yr, Cm[ks], xr, 0, 0, 0); xr = __builtin_amdgcn_mfma_f32_16x16x32_bf16(yi, Sm[ks], xr, 0, 0, 0);
                    xi = __builtin_amdgcn_mfma_f32_16x16x32_bf16(yi, Cm[ks], xi, 0, 0, 0); xi = __builtin_amdgcn_mfma_f32_16x16x32_bf16(yr, nSm[ks], xi, 0, 0, 0); }
#pragma unroll
                for (int r = 0; r < 4; ++r) { Xr[nt][r] = xr[r] * twc[nt][r] + xi[r] * tws[nt][r]; Xi[nt][r] = xi[r] * twc[nt][r] - xr[r] * tws[nt][r]; }
            }
            union { bf16x8 v; unsigned wd[4]; } Br[2], Bi[2], nBr[2];
#pragma unroll
            for (int ks = 0; ks < 2; ++ks) {
                Br[ks].wd[0] = pack2(Xr[2 * ks][0], Xr[2 * ks][1]); Br[ks].wd[1] = pack2(Xr[2 * ks][2], Xr[2 * ks][3]); Br[ks].wd[2] = pack2(Xr[2 * ks + 1][0], Xr[2 * ks + 1][1]); Br[ks].wd[3] = pack2(Xr[2 * ks + 1][2], Xr[2 * ks + 1][3]);
                Bi[ks].wd[0] = pack2(Xi[2 * ks][0], Xi[2 * ks][1]); Bi[ks].wd[1] = pack2(Xi[2 * ks][2], Xi[2 * ks][3]); Bi[ks].wd[2] = pack2(Xi[2 * ks + 1][0], Xi[2 * ks + 1][1]); Bi[ks].wd[3] = pack2(Xi[2 * ks + 1][2], Xi[2 * ks + 1][3]);
#pragma unroll
                for (int q = 0; q < 4; ++q) nBr[ks].wd[q] = Br[ks].wd[q] ^ 0x80008000u; }
            f32x4 o[4], oi[4];
#pragma unroll
            for (int p2t = 0; p2t < 4; ++p2t) { f32x4 a = (f32x4){0.f, 0.f, 0.f, 0.f}, ai = (f32x4){0.f, 0.f, 0.f, 0.f};
#pragma unroll
                for (int ks = 0; ks < 2; ++ks) { const bf16x8 cg = *(const LAS bf16x8*)(G2 + ((p2t * 2 + ks) * 2) * 1024 + lane * 16), sg = *(const LAS bf16x8*)(G2 + ((p2t * 2 + ks) * 2 + 1) * 1024 + lane * 16);
                    a = __builtin_amdgcn_mfma_f32_16x16x32_bf16(cg, Br[ks].v, a, 0, 0, 0); a = __builtin_amdgcn_mfma_f32_16x16x32_bf16(sg, Bi[ks].v, a, 0, 0, 0);
                    if (want_im) { ai = __builtin_amdgcn_mfma_f32_16x16x32_bf16(cg, Bi[ks].v, ai, 0, 0, 0); ai = __builtin_amdgcn_mfma_f32_16x16x32_bf16(sg, nBr[ks].v, ai, 0, 0, 0); } }
                o[p2t] = a; oi[p2t] = ai; }
            __syncthreads();
#pragma unroll
            for (int p2t = 0; p2t < 4; ++p2t)
#pragma unroll
                for (int r = 0; r < 4; ++r) { const int po = ((16 * p2t + 4 * fq + r) * 64 + 16 * pt + fr) * 2; *(LAS bf16_t*)(Pr + po) = f2bf(o[p2t][r]); if (want_im) *(LAS bf16_t*)(Pi + po) = f2bf(oi[p2t][r]); }
        }
        __syncthreads();
#pragma unroll
        for (int hb = 0; hb < 2; ++hb) { FFT_OPQ
#pragma unroll
          for (int i = 0; i < 4; ++i) { const int pp = tid + NTHREADS * (hb * 4 + i), pm = (SEQ - pp) & (SEQ - 1); const size_t tok = (size_t)bl * SEQ + pp;
            const unsigned z0[4] = {zv[hb * 4 + i][0].x, zv[hb * 4 + i][0].y, zv[hb * 4 + i][0].z, zv[hb * 4 + i][0].w}, z1[4] = {zv[hb * 4 + i][1].x, zv[hb * 4 + i][1].y, zv[hb * 4 + i][1].z, zv[hb * 4 + i][1].w};
            float yd[8], ym[8];
#pragma unroll
            for (int c = 0; c < 8; ++c) { yd[c] = bf2f(*(const LAS bf16_t*)(lds + c * 8192 + pp * 2)); ym[c] = bf2f(*(const LAS bf16_t*)(lds + c * 8192 + pm * 2)); }
            if (special) { const float gi0 = bf2f(*(const LAS bf16_t*)(lds + 8 * 8192 + pp * 2)), gi1 = bf2f(*(const LAS bf16_t*)(lds + 8 * 8192 + pm * 2));
                const float a0 = 0.5f * (yd[0] + ym[0]); yd[0] = a0; ym[0] = 0.5f * (gi0 + gi1); }
#pragma unroll
            for (int c = 0; c < 8; ++c) { yd[c] *= silu_f(bfw(z0, c)); ym[c] *= silu_f(bfw(z1, c)); }
            *(uint4*)(Yout + tok * E + sl * 16) = make_uint4(pack2(yd[0], yd[1]), pack2(yd[2], yd[3]), pack2(yd[4], yd[5]), pack2(yd[6], yd[7]));
            *(uint4*)(Yout + tok * E + sl * 16 + 8) = make_uint4(pack2(ym[0], ym[1]), pack2(ym[2], ym[3]), pack2(ym[4], ym[5]), pack2(ym[6], ym[7])); }
          asm volatile("" ::: "memory"); }
    }
    __syncthreads();
}
#undef FFT_OPQ
__device__ __forceinline__ void phase_ctxdft(LAS unsigned char* lds, const bf16_t* YZ, bf16_t* Yout, int nbat, int tlat, const bf16_t* Tc) {
    const int tid = opq_tid(), lane = tid & 63, w = tid >> 6, fr = lane & 15, fq = lane >> 4;
    LAS unsigned char* Yt = lds;
    LAS float* Ot = (LAS float*)(lds + 16 * 528);
    for (int slab = blockIdx.x; slab < nbat * 128; slab += gridDim.x) {
        const int bl = slab >> 7, id = slab & 127, sl = (id & 7) * 16 + (id >> 3);
        const bool special = (sl & 15) == 0;
        __syncthreads();
        if (tid < 256) { const bf16_t* gp = YZ + ((size_t)tlat + bl * CTX + tid) * YZW + sl * 16; const uint4 a = *(const uint4*)gp, b = *(const uint4*)(gp + 8);
            const unsigned aw[4] = {a.x, a.y, a.z, a.w}, bw[4] = {b.x, b.y, b.z, b.w};
#pragma unroll
            for (int c = 0; c < 8; ++c) { *(LAS bf16_t*)(Yt + c * 528 + tid * 2) = (bf16_t)((c & 1) ? (aw[c >> 1] >> 16) : (aw[c >> 1] & 0xffffu));
                *(LAS bf16_t*)(Yt + (8 + c) * 528 + tid * 2) = (bf16_t)((c & 1) ? (bw[c >> 1] >> 16) : (bw[c >> 1] & 0xffffu)); } }
        __syncthreads();
#pragma unroll
        for (int q = 0; q < 2; ++q) { const int pt = 2 * w + q;
            f32x4 ac = (f32x4){0.f, 0.f, 0.f, 0.f}, as = (f32x4){0.f, 0.f, 0.f, 0.f};
            { const bf16_t* T = Tc;
                bf16x8 a1[8], a2[8];
#pragma unroll
                for (int ks = 0; ks < 8; ++ks) { const bf16_t* tp = T + (size_t)(16 * pt + fr) * 256 + 32 * ks + 8 * fq; const uint4 u1 = *(const uint4*)tp, u2 = *(const uint4*)(tp + 65536);
                    union { bf16x8 v; unsigned wd[4]; } t1, t2; t1.wd[0] = u1.x; t1.wd[1] = u1.y; t1.wd[2] = u1.z; t1.wd[3] = u1.w; t2.wd[0] = u2.x; t2.wd[1] = u2.y; t2.wd[2] = u2.z; t2.wd[3] = u2.w; a1[ks] = t1.v; a2[ks] = t2.v; }
#pragma unroll
                for (int ks = 0; ks < 8; ++ks) { const bf16x8 bb = *(const LAS bf16x8*)(Yt + fr * 528 + (32 * ks + 8 * fq) * 2);
                    ac = __builtin_amdgcn_mfma_f32_16x16x32_bf16(a1[ks], bb, ac, 0, 0, 0); as = __builtin_amdgcn_mfma_f32_16x16x32_bf16(a2[ks], bb, as, 0, 0, 0); }
            }
#pragma unroll
            for (int r = 0; r < 4; ++r) { const float s_im = __shfl_down(as[r], 8), c_im = __shfl_down(ac[r], 8);
                float dv = ac[r] + s_im, mv = ac[r] - s_im;
                if (special && fr == 0) { dv = ac[r]; mv = c_im; }
                if (fr < 8) { const int pp = 16 * pt + 4 * fq + r; Ot[pp * 16 + fr] = dv; Ot[pp * 16 + 8 + fr] = mv; } }
        }
        __syncthreads();
        { const int pp = tid >> 1, hsel = tid & 1; const size_t tok = (size_t)tlat + bl * CTX + pp;
          const f32x4 o0 = *(const LAS f32x4*)(Ot + pp * 16 + hsel * 8), o1 = *(const LAS f32x4*)(Ot + pp * 16 + hsel * 8 + 4); const float ow[8] = {o0[0], o0[1], o0[2], o0[3], o1[0], o1[1], o1[2], o1[3]};
          const uint4 zv = *(const uint4*)(YZ + tok * YZW + 2048 + sl * 16 + hsel * 8); const unsigned zw[4] = {zv.x, zv.y, zv.z, zv.w};
          float y[8];
#pragma unroll
          for (int c = 0; c < 8; ++c) y[c] = ow[c] * silu_f(bfw(zw, c));
          *(uint4*)(Yout + tok * E + sl * 16 + hsel * 8) = make_uint4(pack2(y[0], y[1]), pack2(y[2], y[3]), pack2(y[4], y[5]), pack2(y[6], y[7])); }
    }
    __syncthreads();
}

__device__ __forceinline__ void phase_hstats(int nrows, const bf16_t* Hf, const bf16_t* Hr, float* stats) {
    const int tid = opq_tid(), lane = tid & 63, gw = blockIdx.x * 8 + (tid >> 6), nw = gridDim.x * 8;
    for (int t = gw; t < nrows; t += nw) {
        float mu4[NH], rs4[NH];
#pragma unroll
        for (int hh = 0; hh < NH; ++hh) {
            const size_t off = (size_t)t * E + hh * DH + lane * 8;
            const uint4 a = *(const uint4*)(Hf + off), b = *(const uint4*)(Hr + off);
            float hs[8]; const unsigned aw[4] = {a.x, a.y, a.z, a.w}, bw[4] = {b.x, b.y, b.z, b.w};
#pragma unroll
            for (int i = 0; i < 8; ++i) hs[i] = bfw(aw, i) + bfw(bw, i);
            float s = 0.f;
#pragma unroll
            for (int i = 0; i < 8; ++i) s += hs[i];
            const float mu = wave_sum(s) * (1.0f / DH);
            float q = 0.f;
#pragma unroll
            for (int i = 0; i < 8; ++i) { const float d = hs[i] - mu; q += d * d; }
            mu4[hh] = mu; rs4[hh] = rsqrtf(wave_sum(q) * (1.0f / DH) + EPS);
        }
        if (lane == 0) { *(float4*)(stats + (size_t)t * 8) = make_float4(mu4[0], rs4[0], mu4[1], rs4[1]); *(float4*)(stats + (size_t)t * 8 + 4) = make_float4(mu4[2], rs4[2], mu4[3], rs4[3]); }
    }
}
__device__ __forceinline__ void phase_final(const Params& p) {
    const int tid = opq_tid(), lane = tid & 63, gw = blockIdx.x * 8 + (tid >> 6), nw = gridDim.x * 8;
    for (int r = gw; r < NBATCH * SEQ; r += nw) {
        float* dst = p.out + (size_t)r * D; const bf16_t* src = (const bf16_t*)dst; float v[2][8]; float ss = 0.f;
#pragma unroll
        for (int i = 0; i < 2; ++i) { const uint4 a = *(const uint4*)(src + i * 512 + lane * 8); conv_unpack(a, v[i]); }
#pragma unroll
        for (int i = 0; i < 2; ++i)
#pragma unroll
            for (int e = 0; e < 8; ++e) ss += v[i][e] * v[i][e];
        ss = wave_sum(ss); const float rs = rsqrtf(ss * (1.0f / D) + EPS);
        asm volatile("s_waitcnt vmcnt(0)" ::: "memory");
#pragma unroll
        for (int i = 0; i < 2; ++i) { const int c0 = i * 512 + lane * 8;
            const float4 g0 = *(const float4*)(p.norm_f + c0), g1 = *(const float4*)(p.norm_f + c0 + 4);
            *(float4*)(dst + c0) = make_float4(v[i][0] * rs * g0.x, v[i][1] * rs * g0.y, v[i][2] * rs * g0.z, v[i][3] * rs * g0.w);
            *(float4*)(dst + c0 + 4) = make_float4(v[i][4] * rs * g1.x, v[i][5] * rs * g1.y, v[i][6] * rs * g1.z, v[i][7] * rs * g1.w); }
    }
}

__device__ __forceinline__ Params launder_params(Params q) {
    size_t z = 0; asm volatile("" : "+s"(z));
    q.x += z; q.c += z; q.ctx += z; q.c_ctx += z; q.norm_g += z; q.w_ada += z; q.b_ada += z; q.m_w_in += z; q.m_conv_w += z; q.m_conv_b += z; q.m_w_q += z; q.m_w_k += z; q.m_w_if += z;
    q.m_b_i += z; q.m_b_f += z; q.m_ln_w += z; q.m_skip += z; q.m_w_out += z; q.f_w_in += z; q.f_w_out += z; q.norm_f += z; q.out += z; q.ws += z;
    return q;
}
#define PH_BEGIN if (ph >= p0.ph_lo && ph < p0.ph_hi) { const Params p = launder_params(p0); unsigned char* ws = p.ws; int G = G0, cid = cid0; asm volatile("" : "+s"(G), "+s"(cid)); (void)G; (void)cid; \
        bf16_t* HMOD = (bf16_t*)(ws + WS_HMOD); bf16_t* B0 = (bf16_t*)(ws + WS_B0); bf16_t* B1 = (bf16_t*)(ws + WS_B0 + BUFSZ); bf16_t* B2 = (bf16_t*)(ws + WS_B0 + 2 * BUFSZ); \
        bf16_t* B3 = (bf16_t*)(ws + WS_B0 + 3 * BUFSZ); bf16_t* B4 = (bf16_t*)(ws + WS_B0 + 4 * BUFSZ); bf16_t* B5 = (bf16_t*)(ws + WS_B0 + 5 * BUFSZ); \
        float* LI = (float*)(ws + WS_LI); float* LF = (float*)(ws + WS_LF); bf16_t* XCs = (bf16_t*)(ws + WS_XC); const float* mods = (const float*)(ws + WS_MODS); \
        bf16_t* W1 = (bf16_t*)(ws + WS_W1); bf16_t* W2 = (bf16_t*)(ws + WS_W2); bf16_t* W3 = (bf16_t*)(ws + WS_W3); \
        (void)HMOD; (void)B0; (void)B1; (void)B2; (void)B3; (void)B4; (void)B5; (void)LI; (void)LF; (void)XCs; (void)mods; (void)W1; (void)W2; (void)W3;
#define PH_BAR(FIRST) { XcdBarrier bb = bar; { size_t z_ = 0; asm volatile("" : "+s"(z_), "+s"(bb.x)); bb.bar += z_; } xcd_barrier<FIRST>(bb); }
#define PH_END0  if (ph + 1 < p0.ph_hi) PH_BAR(true) } ++ph;
#define PH_END   if (ph + 1 < p0.ph_hi) PH_BAR(false) } ++ph;
#define PREP_EARLY(LAYER, BID, NB) do { const int jj_ = (LAYER) >> 1; \
        if (((LAYER) & 1) == 0) { phase_gfold(p, jj_, (bf16_t*)(ws + WS_WG), (BID), (NB)); \
            phase_transpose(lds, p.m_w_in + (size_t)jj_ * D * 6144, W1, D, 6144, 6144, 1, 0, 0, (BID), (NB)); \
            phase_transpose(lds, p.m_w_q + (size_t)jj_ * NH * DH * DH, W2, DH, DH, DH, NH, (size_t)DH * DH, (size_t)DH * DH, (BID), (NB)); \
            phase_transpose(lds, p.m_w_k + (size_t)jj_ * NH * DH * DH, W2 + (size_t)NH * DH * DH, DH, DH, DH, NH, (size_t)DH * DH, (size_t)DH * DH, (BID), (NB)); } \
        else { phase_transpose<1>(lds, p.f_w_in + (size_t)jj_ * D * 4096 + E, W1 + (size_t)2048 * D, D, E, 4096, 1, 0, 0, (BID), (NB)); } } while (0)
#define HMSR const bf16_t* HM = HMOD + (size_t)hf * TH * D; bf16_t* SR = HMOD + (size_t)(1 - hf) * TH * D; (void)HM; (void)SR;

template <int layer, int hf>
__device__ __forceinline__ void run_mlstm_half(const Params& p0, LAS unsigned char* lds, const XcdBarrier& bar, int& ph, const int G0, const int cid0) {
    constexpr int j = layer >> 1; constexpr bool upd_ctx = layer < 2, ctx_in = layer < 3;
    constexpr int rows_in = ctx_in ? TH : TLAT, rows_out = upd_ctx ? TH : TLAT;
    const int wo_units = (rows_out / 256) * 4, wo_busy = wo_units % G0;
    PH_BEGIN { HMSR pg8::Gemm g{HM, W1, TH, E, D, D, D, 1, 1, 0, 0, 0, 0, 0}; pg8::Order S; S.init(TH, E, 1, G, cid);
        pg8::EpiBf16 ep{B0, B0, 1, 0, (size_t)E, 1.0f, 1.0f}; pg8::gemm_phase(lds, g, S, ep); } PH_END
    PH_BEGIN phase_conv(p, j, B0, B1); PH_END
    PH_BEGIN { phase_gates(lds, B1, B0, (const bf16_t*)(ws + WS_WG), LI, LF, p.m_b_i + j * 8, p.m_b_f + j * 8);
        pg8::Gemm g{B1, W2, TH, DH, DH, E, DH, 8, 4, (size_t)DH, (size_t)DH * DH, 0, 0, 0}; pg8::Order S; S.init(TH, DH, 8, G, cid);
        pg8::EpiBf16 ep{B2, B3, 4, DH, (size_t)E, 1.0f, 0.044194173824159216f}; pg8::gemm_phase(lds, g, S, ep); } PH_END
    PH_BEGIN { HMSR pg8::Gemm g{B2, B3, TH, 256, DH, E, E, NH, NH, (size_t)DH, (size_t)DH, 1, 0, 0}; pg8::Order S; S.init(TH, 256, NH, G, cid);
        pg8::EpiSdiag ep{SR, SR + (size_t)HB * NH * 68 * 4096}; pg8::gemm_phase(lds, g, S, ep); } PH_END
    PH_BEGIN { HMSR phase_scan(lds, B2, B3, B0, SR, LI, LF, B4, B5); } PH_END
    PH_BEGIN phase_hstats(rows_out, B4, B5, LI); PH_END
    PH_BEGIN { HMSR pg8::Gemm g{HM, W1 + (size_t)E * D, rows_out, 2 * E, D, D, D, 1, 1, 0, 0, 0, E, 128}; pg8::Order S; S.init(rows_out, 2 * E, 1, G, cid);
        pg8::EpiMout ep{B4, B5, B1, LI, p.m_ln_w + (size_t)j * E, p.m_skip + (size_t)j * E, B0}; pg8::gemm_phase(lds, g, S, ep);
        if (hf == 0) { const int busy = ((rows_out / 256) * 16) % G;
            if (busy == 0) phase_hmod(p, layer, HB, TLAT, rows_in, HMOD + (size_t)TH * D, cid, G);
            else if (cid >= busy) phase_hmod(p, layer, HB, TLAT, rows_in, HMOD + (size_t)TH * D, cid - busy, G - busy); } } PH_END
    PH_BEGIN { pg8::Gemm g{B0, W3, rows_out, D, E, E, E, 1, 1, 0, 0, 0, 0, 0}; pg8::Order S; S.init(rows_out, D, 1, G, cid);
        pg8::EpiResid<layer == 0> er{p.x, p.ctx, (bf16_t*)p.out, XCs, mods + (size_t)layer * 9 * 3072, hf * HB, TLAT}; pg8::gemm_phase(lds, g, S, er);
        if (hf == 1) { if (wo_busy == 0) PREP_EARLY(layer + 1, cid, G); else if (cid >= wo_busy) PREP_EARLY(layer + 1, cid - wo_busy, G - wo_busy); } } PH_END
}
template <int layer>
__device__ __forceinline__ void run_layer(const Params& p0, LAS unsigned char* lds, const XcdBarrier& bar, int& ph, const int G0, const int cid0) {
    constexpr int j = layer >> 1;
    constexpr bool upd_ctx = layer < 2;
    constexpr bool ctx_in = layer < 3;
    if constexpr ((layer & 1) == 0) {
        constexpr int rows_in = ctx_in ? TH : TLAT;
        PH_BEGIN if (layer == 0) PREP_EARLY(0, cid, G);
            phase_transpose(lds, p.m_w_out + (size_t)j * E * D, W3, E, D, D, 1, 0, 0, cid, G);
            phase_hmod(p, layer, 0, TLAT, rows_in, HMOD, cid, G); PH_END
        run_mlstm_half<layer, 0>(p0, lds, bar, ph, G0, cid0);
        run_mlstm_half<layer, 1>(p0, lds, bar, ph, G0, cid0);
    } else {
        constexpr int TLF = NBATCH * SEQ;
        constexpr int rin = ctx_in ? (TLF + NBATCH * CTX) : TLF, rout = upd_ctx ? (TLF + NBATCH * CTX) : TLF;
        const int fo_busy = ((rout / 256) * 4) % G0;
        PH_BEGIN {
            phase_transpose<2>(lds, p.f_w_out + (size_t)j * E * D, W3, E, D, D, 1, 0, 0, cid, G);
            const GSeg sg[1] = {{p.f_w_in + (size_t)j * D * 4096, (const float*)(ws + WS_FC), 256}}; EpiFold ef{W1};
            gemm_generic<float, float, 1>(lds, sg, 4096, 256, D, 256, 8, 256, 0, ef);
            phase_hmod(p, layer, 0, TLF, rin, HMOD, cid, G); } PH_END
        PH_BEGIN { pg8::Gemm g{HMOD, W1, rin, YZW, D, D, D, 1, 1, 0, 0, 0, 0, 0}; pg8::Order S; S.init(rin, YZW, 1, G, cid);
            pg8::EpiBf16 ep{B0, B0, 1, 0, (size_t)YZW, 1.0f, 1.0f}; pg8::gemm_phase(lds, g, S, ep); } PH_END
        PH_BEGIN { phase_fft(lds, B0, B4, NBATCH); if (upd_ctx) phase_ctxdft(lds, B0, B4, NBATCH, TLF, (const bf16_t*)(ws + WS_TCTX)); } PH_END
        PH_BEGIN { pg8::Gemm g{B4, W3, rout, D, E, E, E, 1, 1, 0, 0, 0, 0, 0}; pg8::Order S; S.init(rout, D, 1, G, cid);
            pg8::EpiResid<false> er{p.x, p.ctx, (bf16_t*)p.out, XCs, mods + (size_t)layer * 9 * 3072, 0, TLF}; pg8::gemm_phase(lds, g, S, er);
            if (layer < 3) { if (fo_busy == 0) PREP_EARLY(layer + 1, cid, G); else if (cid >= fo_busy) PREP_EARLY(layer + 1, cid - fo_busy, G - fo_busy); } } PH_END
    }
}

__global__ void __launch_bounds__(NTHREADS, 2) mega(Params p0) {
    extern __shared__ __attribute__((aligned(16))) unsigned char smem[];
    LAS unsigned char* lds = (LAS unsigned char*)smem;
    if (threadIdx.x == 0) *(LAS u32x4*)(lds + L_BARW) = (u32x4){0u, 0u, 0u, 0u};
    __syncthreads();
    const bool single = (p0.ph_hi - p0.ph_lo) > 1;
    XcdBarrier bar; bar.bar = (unsigned*)(p0.ws + WS_BAR); bar.x = 0; bar.st = (volatile LAS unsigned*)(lds + L_BARW);
    if (single) bar = xcd_barrier_post((unsigned*)(p0.ws + WS_BAR), (volatile LAS unsigned*)(lds + L_BARW));
    int ph = 0;
    const int G0 = (int)gridDim.x, cid0 = (int)blockIdx.x;
    PH_BEGIN phase_mods(p, lds); phase_tables(p); PH_END0
    run_layer<0>(p0, lds, bar, ph, G0, cid0);
    run_layer<1>(p0, lds, bar, ph, G0, cid0);
    run_layer<2>(p0, lds, bar, ph, G0, cid0);
    run_layer<3>(p0, lds, bar, ph, G0, cid0);
    PH_BEGIN phase_final(p); PH_END
}

extern "C" void kernel_launch(void* const* d_in, const int* in_sizes, int n_in, void* d_out, int out_size, void* d_ws, size_t ws_size, hipStream_t stream) {
    static int ready = 0;
    if (!ready) {
        if (hipFuncSetAttribute((const void*)mega, hipFuncAttributeMaxDynamicSharedMemorySize, LDS_BYTES) != hipSuccess) fprintf(stderr, "hipFuncSetAttribute failed\n");
        (void)hipGetLastError();
        ready = 1;
    }
    (void)hipMemsetAsync((unsigned char*)d_ws + WS_BAR, 0, 16384, stream);
    Params p{};
    p.x = (const float*)d_in[0]; p.c = (const float*)d_in[1]; p.ctx = (const float*)d_in[2]; p.c_ctx = (const float*)d_in[3]; p.norm_g = (const float*)d_in[4];
    p.w_ada = (const float*)d_in[5]; p.b_ada = (const float*)d_in[6]; p.m_w_in = (const float*)d_in[7]; p.m_conv_w = (const float*)d_in[8]; p.m_conv_b = (const float*)d_in[9];
    p.m_w_q = (const float*)d_in[10]; p.m_w_k = (const float*)d_in[11]; p.m_w_if = (const float*)d_in[12]; p.m_b_i = (const float*)d_in[13]; p.m_b_f = (const float*)d_in[14];
    p.m_ln_w = (const float*)d_in[15]; p.m_skip = (const float*)d_in[16]; p.m_w_out = (const float*)d_in[17]; p.f_w_in = (const float*)d_in[18]; p.f_w_out = (const float*)d_in[19];
    p.norm_f = (const float*)d_in[20]; p.out = (float*)d_out; p.ws = (unsigned char*)d_ws;
    p.ph_lo = 0; p.ph_hi = 1000;
    hipLaunchKernelGGL(mega, dim3(256), dim3(NTHREADS), LDS_BYTES, stream, p);
}
```

```cpp
#include <hip/hip_runtime.h>
#include <stdint.h>
#include <stdio.h>

#define LAS __attribute__((address_space(3)))
typedef unsigned short bf16_t;
typedef short bf16x8 __attribute__((ext_vector_type(8)));
typedef float f32x4 __attribute__((ext_vector_type(4)));
typedef unsigned u32x4 __attribute__((ext_vector_type(4)));
typedef unsigned u32x2 __attribute__((ext_vector_type(2)));
typedef short s16x4 __attribute__((ext_vector_type(4)));

constexpr int D = 1024, E = 2048, SEQ = 4096, CTX = 256, NBATCH = 8, NH = 4, DH = 512;
constexpr int HB = 4;
constexpr int TLAT = HB * SEQ;
constexpr int TCTX = HB * CTX;
constexpr int TH = TLAT + TCTX;
constexpr int NTHREADS = 512;
constexpr float EPS = 1e-6f;

constexpr size_t al256(size_t x) { return (x + 255) & ~(size_t)255; }
constexpr size_t WS_BAR = 0;
constexpr size_t WS_MODS = 16384;
constexpr size_t WS_XC = al256(WS_MODS + (size_t)4 * 9 * 3072 * 4);
constexpr size_t WS_LI = al256(WS_XC + (size_t)NBATCH * CTX * D * 4);
constexpr size_t WS_LF = al256(WS_LI + (size_t)2 * TH * 4 * 4);
constexpr size_t WS_FC = al256(WS_LF + (size_t)2 * TH * 4 * 4);
constexpr size_t WS_TCTX = al256(WS_FC + (size_t)256 * 512 * 4);
constexpr size_t WS_WG = al256(WS_TCTX + (size_t)256 * 512 * 2);
constexpr size_t WS_W1 = al256(WS_WG + (size_t)6144 * 128 * 4);
constexpr size_t WS_W2 = al256(WS_W1 + (size_t)6144 * 1024 * 2);
constexpr size_t WS_W3 = al256(WS_W2 + (size_t)8 * 512 * 512 * 2);
constexpr size_t WS_HMOD = al256(WS_W3 + (size_t)1024 * 2048 * 2);
constexpr size_t BUFSZ = (size_t)TH * E * 2;
constexpr size_t WS_B0 = al256(WS_HMOD + (size_t)2 * TH * D * 2);
constexpr size_t WS_END = WS_B0 + 6 * BUFSZ;
static_assert(WS_END <= ((size_t)512 << 20), "workspace overflow");

constexpr int QROW = 1040;
constexpr int KROW = 1088;
constexpr int L_QS = 0, L_KS = 64 * QROW;
constexpr int L_SARR = 64 * QROW + 64 * KROW;
constexpr int L_SDEN = L_SARR + 2 * 5 * 256;
constexpr int L_ROWREC = L_SDEN + 2048 + 256 + 16;
constexpr int L_VS = L_ROWREC + 1024;
constexpr int L_XCH = L_VS + 8192;
constexpr int L_BARW = 163824;
constexpr int LDS_BYTES = L_BARW + 16;
static_assert(LDS_BYTES <= 160 * 1024 && L_XCH + 8192 <= L_BARW, "LDS overflow");

#define XB_TMO      128
#define XB_XCNT(j)  (256  + 64 * (j))
#define XB_XSUB(j)  (1280 + 64 * (j))
#define XB_XGEN(j)  (2304 + 64 * (j))
#define XB_TOP      3328
#define XB_TOPGEN   3392
#define XCD_BAR_WORDS 3456
#define XB_SPIN_CAP (1u << 22)

__device__ __forceinline__ unsigned xb_ld(unsigned* p)              { return __hip_atomic_load(p, __ATOMIC_RELAXED, __HIP_MEMORY_SCOPE_AGENT); }
__device__ __forceinline__ unsigned xb_add(unsigned* p, unsigned v) { return __hip_atomic_fetch_add(p, v, __ATOMIC_RELAXED, __HIP_MEMORY_SCOPE_AGENT); }
__device__ __forceinline__ unsigned xb_xcc_id() { return (unsigned)__builtin_amdgcn_s_getreg((3 << 11) | 20) & 0xFu; }
#define XB_SPIN(cond, bar) do { unsigned _sp = 0; while (cond) { __builtin_amdgcn_s_sleep(1); \
    if ((++_sp & 255u) == 0u) { if (xb_ld(&(bar)[XB_TMO])) break; if (_sp > XB_SPIN_CAP) { atomicAdd(&(bar)[XB_TMO], 1u); break; } } } } while (0)

struct XcdBarrier { unsigned* bar; unsigned x; volatile LAS unsigned* st; };

__device__ __forceinline__ XcdBarrier xcd_barrier_post(unsigned* bar, volatile LAS unsigned* st) {
    XcdBarrier b; b.bar = bar; b.x = xb_xcc_id(); b.st = st;
    if (threadIdx.x == 0) (void)xb_add(&bar[XB_XCNT(b.x)], 1u);
    return b;
}
__device__ __forceinline__ void xcd_barrier_complete(unsigned* bar, unsigned x, unsigned& nloc, unsigned& nx) {
    const unsigned G = gridDim.x * gridDim.y * gridDim.z;
    unsigned sum, cnt, mine, sp = 0u;
    for (;;) {
        sum = 0u; cnt = 0u; mine = 0u;
#pragma unroll
        for (unsigned j = 0; j < 16; ++j) { const unsigned c = xb_ld(&bar[XB_XCNT(j)]); sum += c; cnt += (c > 0u) ? 1u : 0u; mine = (j == x) ? c : mine; }
        if (sum == G) break;
        __builtin_amdgcn_s_sleep(1);
        if ((++sp & 255u) == 0u) { if (xb_ld(&bar[XB_TMO])) break; if (sp > XB_SPIN_CAP) { atomicAdd(&bar[XB_TMO], 1u); break; } }
    }
    nloc = mine > 0u ? mine : 1u; nx = cnt > 0u ? cnt : 1u;
}
template <bool FIRST>
__device__ __forceinline__ void xcd_barrier(const XcdBarrier& b) {
    asm volatile("s_waitcnt vmcnt(0)" ::: "memory");
    __syncthreads();
    if (threadIdx.x == 0) {
        unsigned* bar = b.bar;
        __builtin_amdgcn_s_waitcnt(0);
        unsigned nloc = b.st[0], nx = b.st[1];
        if (FIRST) { if (nloc == 0u) { xcd_barrier_complete(bar, b.x, nloc, nx); b.st[0] = nloc; b.st[1] = nx; } }
        const unsigned old = xb_add(&bar[XB_XSUB(b.x)], 1u);
        const unsigned gen = old / nloc;
        if (old + 1u == (gen + 1u) * nloc) {
            __builtin_amdgcn_fence(__ATOMIC_RELEASE, "agent");
            asm volatile("s_waitcnt vmcnt(0)" ::: "memory");
            const unsigned og = xb_add(&bar[XB_TOP], 1u);
            const unsigned tg = og / nx;
            if (og + 1u == (tg + 1u) * nx) xb_add(&bar[XB_TOPGEN], 1u);
            else XB_SPIN(xb_ld(&bar[XB_TOPGEN]) == tg, bar);
            __builtin_amdgcn_fence(__ATOMIC_ACQUIRE, "agent");
            xb_add(&bar[XB_XGEN(b.x)], 1u);
            asm volatile("s_waitcnt vmcnt(0)" ::: "memory");
        } else {
            XB_SPIN(xb_ld(&bar[XB_XGEN(b.x)]) == gen, bar);
            __builtin_amdgcn_fence(__ATOMIC_ACQUIRE, "agent");
            asm volatile("s_waitcnt vmcnt(0)" ::: "memory");
        }
    }
    __syncthreads();
}

typedef float f32x2 __attribute__((ext_vector_type(2)));
typedef __bf16 bf16x2_t __attribute__((ext_vector_type(2)));
__device__ __forceinline__ unsigned pack2(float lo, float hi) { const f32x2 f = {lo, hi}; const bf16x2_t h = __builtin_convertvector(f, bf16x2_t); return __builtin_bit_cast(unsigned, h); }
__device__ __forceinline__ bf16_t f2bf(float f) { return (bf16_t)(pack2(f, 0.f) & 0xffffu); }
__device__ __forceinline__ float bf2f(bf16_t b) { return __uint_as_float(((unsigned)b) << 16); }
__device__ __forceinline__ float silu_f(float v) { return v * __builtin_amdgcn_rcpf(1.0f + __expf(-v)); }
__device__ __forceinline__ float sigmoid_f(float v) { return __builtin_amdgcn_rcpf(1.0f + __expf(-v)); }
__device__ __forceinline__ float silu_div(float v) { return v / (1.0f + __expf(-v)); }
__device__ __forceinline__ float sigmoid_div(float v) { return 1.0f / (1.0f + __expf(-v)); }
__device__ __forceinline__ float bfw(const unsigned (&w)[4], int i) { return bf2f((bf16_t)((i & 1) ? (w[i >> 1] >> 16) : (w[i >> 1] & 0xffffu))); }
#define DPP_F(v, ctrl, rmask, bc) __builtin_bit_cast(float, __builtin_amdgcn_update_dpp(0, __builtin_bit_cast(int, (v)), (ctrl), (rmask), 0xf, (bc)))
__device__ __forceinline__ float wave_sum(float v) {
    v += DPP_F(v, 0xB1, 0xf, true); v += DPP_F(v, 0x4E, 0xf, true); v += DPP_F(v, 0x141, 0xf, true); v += DPP_F(v, 0x140, 0xf, true);
    const int iv = __builtin_bit_cast(int, v);
    return (__builtin_bit_cast(float, __builtin_amdgcn_readlane(iv, 0)) + __builtin_bit_cast(float, __builtin_amdgcn_readlane(iv, 16)))
         + (__builtin_bit_cast(float, __builtin_amdgcn_readlane(iv, 32)) + __builtin_bit_cast(float, __builtin_amdgcn_readlane(iv, 48)));
}
__device__ __forceinline__ float wave_scan_sum(float v) {
    v += DPP_F(v, 0x111, 0xf, true); v += DPP_F(v, 0x112, 0xf, true); v += DPP_F(v, 0x114, 0xf, true); v += DPP_F(v, 0x118, 0xf, true);
    v += DPP_F(v, 0x142, 0xa, false); v += DPP_F(v, 0x143, 0xc, false);
    return v;
}
#define DPP_FM(v, ctrl, rmask) __builtin_bit_cast(float, __builtin_amdgcn_update_dpp((int)0xff800000, __builtin_bit_cast(int, (v)), (ctrl), (rmask), 0xf, false))
__device__ __forceinline__ float wave_scan_max(float v) {
    v = fmaxf(v, DPP_FM(v, 0x111, 0xf)); v = fmaxf(v, DPP_FM(v, 0x112, 0xf)); v = fmaxf(v, DPP_FM(v, 0x114, 0xf)); v = fmaxf(v, DPP_FM(v, 0x118, 0xf));
    v = fmaxf(v, DPP_FM(v, 0x142, 0xa)); v = fmaxf(v, DPP_FM(v, 0x143, 0xc));
    return v;
}
__device__ __forceinline__ int opq_tid() { int t = threadIdx.x; asm volatile("" : "+v"(t)); return t; }

struct Params {
    const float* x; const float* c; const float* ctx; const float* c_ctx; const float* norm_g; const float* w_ada; const float* b_ada;
    const float* m_w_in; const float* m_conv_w; const float* m_conv_b; const float* m_w_q; const float* m_w_k; const float* m_w_if;
    const float* m_b_i; const float* m_b_f; const float* m_ln_w; const float* m_skip; const float* m_w_out; const float* f_w_in; const float* f_w_out;
    const float* norm_f; float* out; unsigned char* ws; int ph_lo; int ph_hi;
};

struct GSeg { const void* A; const void* B; int K; };
template <typename T> __device__ __forceinline__ void load8_bf16(const T* p, unsigned (&w)[4]);
template <> __device__ __forceinline__ void load8_bf16<float>(const float* p, unsigned (&w)[4]) {
    const float4 a = *(const float4*)p, b = *(const float4*)(p + 4);
    w[0] = pack2(a.x, a.y); w[1] = pack2(a.z, a.w); w[2] = pack2(b.x, b.y); w[3] = pack2(b.z, b.w);
}
template <> __device__ __forceinline__ void load8_bf16<bf16_t>(const bf16_t* p, unsigned (&w)[4]) {
    const uint4 a = *(const uint4*)p; w[0] = a.x; w[1] = a.y; w[2] = a.z; w[3] = a.w;
}
template <typename T> struct Raw8;
template <> struct Raw8<float> { float4 a, b;
    __device__ __forceinline__ void load(const float* p) { a = *(const float4*)p; b = *(const float4*)(p + 4); }
    __device__ __forceinline__ void pack(unsigned (&w)[4]) const { w[0] = pack2(a.x, a.y); w[1] = pack2(a.z, a.w); w[2] = pack2(b.x, b.y); w[3] = pack2(b.z, b.w); } };
template <> struct Raw8<bf16_t> { uint4 a;
    __device__ __forceinline__ void load(const bf16_t* p) { a = *(const uint4*)p; }
    __device__ __forceinline__ void pack(unsigned (&w)[4]) const { w[0] = a.x; w[1] = a.y; w[2] = a.z; w[3] = a.w; } };
template <typename TA, typename TB, int NSEG, class Epi, bool BCOL2 = false>
__device__ __forceinline__ void gemm_generic(LAS unsigned char* lds, const GSeg (&seg)[NSEG], size_t lda, size_t ldb, int M, int N, int nbatch, size_t sA, size_t sB, const Epi& epi) {
    const int tid = opq_tid(), lane = tid & 63, w = tid >> 6, fr = lane & 15, fq = lane >> 4, wm = w >> 2, wn = w & 3;
    LAS unsigned char* As = lds; LAS unsigned char* Bs = lds + 128 * 80;
    const int tm = M / 128, tn = N / 128, ntile = nbatch * tm * tn;
    const int arow = tid >> 2, ac8 = (tid & 3) * 8, bk = tid >> 4, bn8 = (tid & 15) * 8;
    for (int tile = blockIdx.x; tile < ntile; tile += gridDim.x) {
        const int batch = tile / (tm * tn), rem = tile % (tm * tn), m0 = (rem / tn) * 128, n0 = (rem % tn) * 128;
        f32x4 acc[4][2];
#pragma unroll
        for (int i = 0; i < 4; ++i)
#pragma unroll
            for (int j = 0; j < 2; ++j) acc[i][j] = (f32x4){0.f, 0.f, 0.f, 0.f};
#pragma unroll
        for (int sg = 0; sg < NSEG; ++sg) {
            const TA* Ab = (const TA*)seg[sg].A + batch * sA + (size_t)(m0 + arow) * lda + ac8;
            const TB* Bb = (const TB*)seg[sg].B + batch * sB + (size_t)bk * ldb + (BCOL2 ? 2 : 1) * (n0 + bn8);
            Raw8<TA> ra; Raw8<TB> rb;
            ra.load(Ab); rb.load(Bb);
            for (int k0 = 0; k0 < seg[sg].K; k0 += 32) {
                unsigned aw[4], bw[4];
                ra.pack(aw); rb.pack(bw);
                __syncthreads();
                *(LAS u32x4*)(As + arow * 80 + ac8 * 2) = (u32x4){aw[0], aw[1], aw[2], aw[3]};
#pragma unroll
                for (int i = 0; i < 4; ++i) {
                    *(LAS bf16_t*)(Bs + (bn8 + 2 * i) * 80 + bk * 2) = (bf16_t)(bw[i] & 0xffffu);
                    *(LAS bf16_t*)(Bs + (bn8 + 2 * i + 1) * 80 + bk * 2) = (bf16_t)(bw[i] >> 16);
                }
                if (k0 + 32 < seg[sg].K) {
                    ra.load(Ab + k0 + 32);
                    rb.load(Bb + (size_t)(k0 + 32) * ldb);
                }
                __syncthreads();
                bf16x8 af[4], bfr[2];
#pragma unroll
                for (int i = 0; i < 4; ++i) af[i] = *(const LAS bf16x8*)(As + (wm * 64 + i * 16 + fr) * 80 + fq * 16);
#pragma unroll
                for (int j = 0; j < 2; ++j) bfr[j] = *(const LAS bf16x8*)(Bs + (wn * 32 + j * 16 + fr) * 80 + fq * 16);
#pragma unroll
                for (int i = 0; i < 4; ++i)
#pragma unroll
                    for (int j = 0; j < 2; ++j) acc[i][j] = __builtin_amdgcn_mfma_f32_16x16x32_bf16(af[i], bfr[j], acc[i][j], 0, 0, 0);
            }
        }
#pragma unroll
        for (int i = 0; i < 4; ++i)
#pragma unroll
            for (int j = 0; j < 2; ++j)
#pragma unroll
                for (int r = 0; r < 4; ++r) epi(batch, m0 + wm * 64 + i * 16 + fq * 4 + r, n0 + wn * 32 + j * 16 + fr, acc[i][j][r]);
    }
    __syncthreads();
}


namespace pg8 {
constexpr int BM = 256, BK = 64, HALF = 128, HTB = HALF * BK * 2, NXCD = 8, WGM = 8;
__device__ __forceinline__ int lds_byte(int r, int c) { const int st = (r >> 4) * 2 + (c >> 5), rr = r & 15, cc = c & 31, ob = rr * 64 + cc * 2; return st * 1024 + (ob ^ (((ob >> 9) & 1) << 5)); }
__device__ __forceinline__ void stage_rc(int b, int& R, int& C) { const int st = b / 1024, sb = b % 1024, swz = sb ^ (((sb >> 9) & 1) << 5); R = (st >> 1) * 16 + swz / 64; C = (st & 1) * 32 + (swz % 64) / 2; }
__device__ __forceinline__ int perm32(int rho) { const int n = rho >> 4, i = rho & 15; return 8 * (i >> 2) + 4 * n + (i & 3); }
struct Unit { int pm, pn, b; };
struct Gemm { const bf16_t* A; const bf16_t* Bt; int M, N, K, lda, ldb, nb, nbA; size_t sAb, sBb; int diag; int bh_rows, bt_rows; };
struct Order {
    int nM, nN, nwg, G, c;
    __device__ void init(int M, int N, int nb, int G_, int c_) { nM = M / BM; nN = N / BM; nwg = nb * nM * nN; G = G_; c = c_; }
    __device__ bool next(int i, Unit& u) const {
        const long L = (long)i * G + c; if (L >= nwg) return false;
        int wgid = (int)L; { const int q = nwg / NXCD, r = nwg % NXCD, xcd = wgid % NXCD, off = wgid / NXCD; wgid = (xcd < r ? xcd * (q + 1) : r * (q + 1) + (xcd - r) * q) + off; }
        const int nMv = nwg / nN, nig = WGM * nN, gid = wgid / nig, fm = gid * WGM, gsz = (nMv - fm) < WGM ? (nMv - fm) : WGM;
        const int vm = fm + ((wgid % nig) % gsz); u.pn = (wgid % nig) / gsz; u.b = vm / nM; u.pm = vm % nM; return true;
    }
};
__device__ __forceinline__ unsigned cvt_pk_bf16(float lo, float hi) { unsigned r; asm volatile("v_cvt_pk_bf16_f32 %0, %1, %2" : "=v"(r) : "v"(lo), "v"(hi)); return r; }

template <class Epi>
__device__ __forceinline__ void gemm_phase(LAS unsigned char* lds, const Gemm g, const Order& S, const Epi& E) {
    const int tid = opq_tid(), wid = __builtin_amdgcn_readfirstlane(tid >> 6), lane = tid & 63, wr = wid >> 2, wc = wid & 3, fr = lane & 15, fq = lane >> 4;
    const int K = g.K, nt = K / BK;
    unsigned voffA[2], voffB[2];
#pragma unroll
    for (int i = 0; i < 2; ++i) { int R, C; stage_rc(tid * 16 + i * 8192, R, C); const int Rb = Epi::PERM ? ((R & ~31) + perm32(R & 31)) : R;
        voffA[i] = (unsigned)(R * g.lda + C) * 2u; voffB[i] = (unsigned)(Rb * g.ldb + C) * 2u; }
    const size_t kstep = (size_t)(BK * 2);
    const size_t hstepA = (size_t)HALF * g.lda * 2, hstepB = (size_t)(g.bh_rows ? g.bh_rows : HALF) * g.ldb * 2;
    const size_t tstepA = 2 * hstepA, tstepB = (size_t)(g.bt_rows ? g.bt_rows : 2 * HALF) * g.ldb * 2;
    const unsigned ldsw = (unsigned)wid * 1024u;
    const int aoff = lds_byte(wr * 64 + fr, fq * 8), boff = lds_byte(wc * 32 + fr, fq * 8);
#define PG8_SA(b, h) (((b) * 2 + (h)) * HTB)
#define PG8_SB(b, h) ((4 + (b) * 2 + (h)) * HTB)
#define PG8_STAGE(bufoff, gbase, voff) do { _Pragma("unroll") for (int _i = 0; _i < 2; ++_i) \
        __builtin_amdgcn_global_load_lds((const unsigned*)((const char*)(gbase) + (voff)[_i]), (LAS unsigned*)(lds + (bufoff) + ldsw + _i * 8192), 16, 0, 0); } while (0)
#define PG8_LDA(dst, b, h) do { _Pragma("unroll") for (int m = 0; m < 4; ++m) _Pragma("unroll") for (int k = 0; k < 2; ++k) dst[m][k] = *(const LAS bf16x8*)(lds + PG8_SA(b, h) + aoff + m * 2048 + k * 1024); } while (0)
#define PG8_LDB(dst, b, h) do { _Pragma("unroll") for (int n = 0; n < 2; ++n) _Pragma("unroll") for (int k = 0; k < 2; ++k) dst[n][k] = *(const LAS bf16x8*)(lds + PG8_SB(b, h) + boff + n * 2048 + k * 1024); } while (0)
#define PG8_MMA(ai, bj, At, Bt) do { __builtin_amdgcn_s_setprio(1); _Pragma("unroll") for (int m = 0; m < 4; ++m) _Pragma("unroll") for (int n = 0; n < 2; ++n) _Pragma("unroll") for (int k = 0; k < 2; ++k) \
        acc[ai][bj][m][n] = __builtin_amdgcn_mfma_f32_16x16x32_bf16(Bt[n][k], At[m][k], acc[ai][bj][m][n], 0, 0, 0); __builtin_amdgcn_s_setprio(0); } while (0)
#define PG8_WAIT_V(n) asm volatile("s_waitcnt vmcnt(" #n ")" ::: "memory")
#define PG8_WAIT_L(n) asm volatile("s_waitcnt lgkmcnt(" #n ")" ::: "memory")
#define PG8_WAIT_VE do { if (Epi::NVM == 16) asm volatile("s_waitcnt vmcnt(22)" ::: "memory"); else if (Epi::NVM == 8) asm volatile("s_waitcnt vmcnt(14)" ::: "memory"); else if (Epi::NVM == 32) asm volatile("s_waitcnt vmcnt(38)" ::: "memory"); else asm volatile("s_waitcnt vmcnt(6)" ::: "memory"); } while (0)
#define PG8_BAR __builtin_amdgcn_s_barrier()
#define PG8_SCHED __builtin_amdgcn_sched_barrier(0)
#define PG8_KSTEP(t, PRE) do { \
            const bool last = ((t) == nt - 2); \
            const char* a1 = cA + (size_t)((t) + 1) * kstep; \
            const char* a2 = last ? nA : cA + (size_t)((t) + 2) * kstep; const char* b2 = last ? nB : cB + (size_t)((t) + 2) * kstep; \
            const char* a3 = a2 + kstep; const char* b3 = b2 + kstep; \
            PG8_LDB(B0, 0, 0); PG8_SCHED; PG8_LDA(At, 0, 0); if (!(PRE)) PG8_STAGE(PG8_SA(1, 1), a1 + hstepA, voffA); \
            PG8_WAIT_L(8); PG8_BAR; PG8_WAIT_L(0); PG8_MMA(0, 0, At, B0); PG8_BAR; PG8_SCHED; \
            PG8_LDB(B1, 0, 1); PG8_STAGE(PG8_SB(0, 0), b2, voffB); \
            PG8_BAR; PG8_WAIT_L(0); if (!g.diag) PG8_MMA(0, 1, At, B1); PG8_BAR; \
            PG8_LDA(At, 0, 1); PG8_STAGE(PG8_SA(0, 0), a2, voffA); \
            PG8_BAR; PG8_WAIT_L(0); if (!g.diag) PG8_MMA(1, 0, At, B0); PG8_BAR; PG8_SCHED; \
            PG8_STAGE(PG8_SB(0, 1), b2 + hstepB, voffB); \
            if (PRE) PG8_WAIT_VE; else PG8_WAIT_V(6); PG8_BAR; PG8_MMA(1, 1, At, B1); PG8_BAR; \
            PG8_LDB(B0, 1, 0); PG8_SCHED; PG8_LDA(At, 1, 0); PG8_STAGE(PG8_SA(0, 1), a2 + hstepA, voffA); \
            PG8_WAIT_L(8); PG8_BAR; PG8_WAIT_L(0); PG8_MMA(0, 0, At, B0); PG8_BAR; PG8_SCHED; \
            PG8_LDB(B1, 1, 1); PG8_STAGE(PG8_SB(1, 0), b3, voffB); \
            PG8_BAR; PG8_WAIT_L(0); if (!g.diag) PG8_MMA(0, 1, At, B1); PG8_BAR; \
            PG8_LDA(At, 1, 1); PG8_STAGE(PG8_SA(1, 0), a3, voffA); \
            PG8_BAR; PG8_WAIT_L(0); if (!g.diag) PG8_MMA(1, 0, At, B0); PG8_BAR; PG8_SCHED; \
            PG8_STAGE(PG8_SB(1, 1), b3 + hstepB, voffB); \
            PG8_WAIT_V(6); PG8_BAR; PG8_MMA(1, 1, At, B1); PG8_BAR; } while (0)
#define PG8_ZERO_ACC do { _Pragma("unroll") for (int a = 0; a < 2; ++a) _Pragma("unroll") for (int b = 0; b < 2; ++b) _Pragma("unroll") for (int m = 0; m < 4; ++m) \
        _Pragma("unroll") for (int n = 0; n < 2; ++n) { acc[a][b][m][n] = (f32x4){0.f, 0.f, 0.f, 0.f}; asm volatile("" : "+v"(acc[a][b][m][n])); } } while (0)
#define PG8_NEXT_PTRS do { has_next = S.next(ui + 1, nxt); \
        nA = has_next ? (const char*)(g.A + (size_t)(nxt.b % g.nbA) * g.sAb) + (size_t)nxt.pm * tstepA : cA; \
        nB = has_next ? (const char*)(g.Bt + (size_t)nxt.b * g.sBb) + (size_t)(g.diag ? nxt.pm : nxt.pn) * tstepB : cB; } while (0)
    Unit cur, nxt; int ui = 0;
    if (!S.next(0, cur)) return;
    f32x4 acc[2][2][4][2];
    PG8_ZERO_ACC;
    bf16x8 At[4][2], B0[2][2], B1[2][2];
    const char* cA = (const char*)(g.A + (size_t)(cur.b % g.nbA) * g.sAb) + (size_t)cur.pm * tstepA; const char* cB = (const char*)(g.Bt + (size_t)cur.b * g.sBb) + (size_t)(g.diag ? cur.pm : cur.pn) * tstepB;
    PG8_STAGE(PG8_SB(0, 0), cB, voffB); PG8_STAGE(PG8_SA(0, 0), cA, voffA); PG8_STAGE(PG8_SB(0, 1), cB + hstepB, voffB); PG8_STAGE(PG8_SA(0, 1), cA + hstepA, voffA);
    if (wr == 1) PG8_BAR;
    PG8_WAIT_V(4); PG8_BAR;
    PG8_STAGE(PG8_SB(1, 0), cB + kstep, voffB); PG8_STAGE(PG8_SA(1, 0), cA + kstep, voffA); PG8_STAGE(PG8_SB(1, 1), cB + hstepB + kstep, voffB);
    PG8_WAIT_V(6); PG8_BAR;
    bool has_next; const char* nA; const char* nB;
    PG8_NEXT_PTRS;
    for (int t = 0; t < nt; t += 2) PG8_KSTEP(t, false);
    for (;;) {
        if (Epi::NVM > 0) { PG8_STAGE(PG8_SA(1, 1), nA + kstep + hstepA, voffA); PG8_SCHED; }
        E(acc, cur, wr, wc, fr, fq);
        PG8_SCHED;
        if (!has_next) break;
        PG8_ZERO_ACC;
        cur = nxt; cA = nA; cB = nB; ++ui;
        PG8_NEXT_PTRS;
        if (Epi::NVM > 0) { PG8_KSTEP(0, true); for (int t = 2; t < nt; t += 2) PG8_KSTEP(t, false); }
        else { for (int t = 0; t < nt; t += 2) PG8_KSTEP(t, false); }
    }
    PG8_WAIT_V(0);
    if (wr == 0) PG8_BAR;
    PG8_BAR;
#undef PG8_SA
#undef PG8_SB
#undef PG8_STAGE
#undef PG8_LDA
#undef PG8_LDB
#undef PG8_MMA
#undef PG8_WAIT_V
#undef PG8_WAIT_L
#undef PG8_WAIT_VE
#undef PG8_KSTEP
#undef PG8_ZERO_ACC
#undef PG8_NEXT_PTRS
#undef PG8_BAR
#undef PG8_SCHED
}
struct EpiBf16 {
    static constexpr bool PERM = true; static constexpr int NVM = 16;
    bf16_t* O0; bf16_t* O1; int nb0; int bcols; size_t ldc; float s0, s1;
    __device__ __forceinline__ void operator()(const f32x4 (&acc)[2][2][4][2], const Unit& u, int wr, int wc, int fr, int fq) const {
        const bool second = u.b >= nb0; bf16_t* O = second ? O1 : O0; const float sc = second ? s1 : s0; const int bb = second ? u.b - nb0 : u.b;
        const int row0 = u.pm * BM + wr * 64 + fr, col0 = bb * bcols + u.pn * BM + wc * 32 + 8 * fq;
#pragma unroll
        for (int ai = 0; ai < 2; ++ai)
#pragma unroll
            for (int m = 0; m < 4; ++m) { bf16_t* rowp = O + (size_t)(row0 + ai * HALF + m * 16) * ldc + col0;
#pragma unroll
                for (int bj = 0; bj < 2; ++bj) { const f32x4 v0 = acc[ai][bj][m][0] * sc, v1 = acc[ai][bj][m][1] * sc;
                    u32x4 w; w.x = cvt_pk_bf16(v0[0], v0[1]); w.y = cvt_pk_bf16(v0[2], v0[3]); w.z = cvt_pk_bf16(v1[0], v1[1]); w.w = cvt_pk_bf16(v1[2], v1[3]);
                    *(u32x4*)(rowp + bj * HALF) = w; } }
    }
};
struct EpiSplitOZ {
    static constexpr bool PERM = true; static constexpr int NVM = 16;
    bf16_t* O0; bf16_t* O1;
    __device__ __forceinline__ void operator()(const f32x4 (&acc)[2][2][4][2], const Unit& u, int wr, int wc, int fr, int fq) const {
        const int ct = u.pn * BM; bf16_t* O = (ct < E) ? O0 : O1; const int row0 = u.pm * BM + wr * 64 + fr, col0 = (ct & (E - 1)) + wc * 32 + 8 * fq;
#pragma unroll
        for (int ai = 0; ai < 2; ++ai)
#pragma unroll
            for (int m = 0; m < 4; ++m) { bf16_t* rowp = O + (size_t)(row0 + ai * HALF + m * 16) * E + col0;
#pragma unroll
                for (int bj = 0; bj < 2; ++bj) { const f32x4 v0 = acc[ai][bj][m][0], v1 = acc[ai][bj][m][1];
                    u32x4 w; w.x = cvt_pk_bf16(v0[0], v0[1]); w.y = cvt_pk_bf16(v0[2], v0[3]); w.z = cvt_pk_bf16(v1[0], v1[1]); w.w = cvt_pk_bf16(v1[2], v1[3]);
                    *(u32x4*)(rowp + bj * HALF) = w; } }
    }
};
struct EpiMout {
    static constexpr bool PERM = true; static constexpr int NVM = 8;
    const bf16_t* Hf; const bf16_t* Hr; const bf16_t* XCV; const float* stats; const float* lnw; const float* skp; bf16_t* Y;
    __device__ __forceinline__ void operator()(f32x4 (&acc)[2][2][4][2], const Unit& u, int wr, int wc, int fr, int fq) const {
        const int f0 = u.pn * HALF + wc * 32 + 8 * fq, head = f0 >> 9, row0 = u.pm * BM + wr * 64 + fr;
        const f32x4 lw0 = *(const f32x4*)(lnw + f0), lw1 = *(const f32x4*)(lnw + f0 + 4), sk0 = *(const f32x4*)(skp + f0), sk1 = *(const f32x4*)(skp + f0 + 4);
        u32x4 a[2][2], b[2][2], xv[2][2]; f32x2 st[2][2]; u32x4 yo[2];
#define EM_LOAD(ai, m0, S) do { _Pragma("unroll") for (int mm = 0; mm < 2; ++mm) { const int row = row0 + (ai) * HALF + ((m0) + mm) * 16; const unsigned off = (unsigned)(row * E + f0); \
            a[S][mm] = *(const u32x4*)(Hf + off); b[S][mm] = *(const u32x4*)(Hr + off); xv[S][mm] = *(const u32x4*)(XCV + off); st[S][mm] = *(const f32x2*)(stats + (unsigned)((row * NH + head) * 2)); } } while (0)
#define EM_GATE(ai, m0) do { _Pragma("unroll") for (int mm = 0; mm < 2; ++mm) _Pragma("unroll") for (int n = 0; n < 2; ++n) _Pragma("unroll") for (int e = 0; e < 4; ++e) { \
            acc[ai][0][(m0) + mm][n][e] = sigmoid_f(acc[ai][0][(m0) + mm][n][e]); acc[ai][1][(m0) + mm][n][e] = silu_f(acc[ai][1][(m0) + mm][n][e]); } } while (0)
#define EM_COMB(ai, m0, S) do { _Pragma("unroll") for (int mm = 0; mm < 2; ++mm) { \
            const unsigned aw[4] = {a[S][mm].x, a[S][mm].y, a[S][mm].z, a[S][mm].w}, bw[4] = {b[S][mm].x, b[S][mm].y, b[S][mm].z, b[S][mm].w}, xw[4] = {xv[S][mm].x, xv[S][mm].y, xv[S][mm].z, xv[S][mm].w}; \
            const f32x4 o0 = acc[ai][0][(m0) + mm][0], o1 = acc[ai][0][(m0) + mm][1], z0 = acc[ai][1][(m0) + mm][0], z1 = acc[ai][1][(m0) + mm][1]; float y[8]; \
            _Pragma("unroll") for (int i = 0; i < 8; ++i) { const float so = (i < 4) ? o0[i & 3] : o1[i & 3], sz = (i < 4) ? z0[i & 3] : z1[i & 3], lw = (i < 4) ? lw0[i & 3] : lw1[i & 3], sk = (i < 4) ? sk0[i & 3] : sk1[i & 3]; \
                const float hn = (bfw(aw, i) + bfw(bw, i) - st[S][mm][0]) * st[S][mm][1] * lw * so; y[i] = (hn + sk * bfw(xw, i)) * sz; } \
            yo[mm].x = cvt_pk_bf16(y[0], y[1]); yo[mm].y = cvt_pk_bf16(y[2], y[3]); yo[mm].z = cvt_pk_bf16(y[4], y[5]); yo[mm].w = cvt_pk_bf16(y[6], y[7]); } } while (0)
#define EM_STORE(ai, m0) do { _Pragma("unroll") for (int mm = 0; mm < 2; ++mm) { const int row = row0 + (ai) * HALF + ((m0) + mm) * 16; *(u32x4*)(Y + (unsigned)(row * E + f0)) = yo[mm]; } } while (0)
#define EM_SB __builtin_amdgcn_sched_barrier(0)
        EM_LOAD(0, 0, 0); EM_SB; EM_GATE(0, 0); EM_SB; EM_LOAD(0, 2, 1); EM_SB; EM_COMB(0, 0, 0); EM_SB;
        EM_LOAD(1, 0, 0); EM_SB; EM_STORE(0, 0); EM_SB; EM_GATE(0, 2); EM_SB; EM_COMB(0, 2, 1); EM_SB;
        EM_LOAD(1, 2, 1); EM_SB; EM_STORE(0, 2); EM_SB; EM_GATE(1, 0); EM_SB; EM_COMB(1, 0, 0); EM_SB;
        EM_STORE(1, 0); EM_SB; EM_GATE(1, 2); EM_SB; EM_COMB(1, 2, 1); EM_STORE(1, 2);
#undef EM_SB
#undef EM_LOAD
#undef EM_GATE
#undef EM_COMB
#undef EM_STORE
    }
};
template <bool SRCF>
struct EpiResid {
    static constexpr bool PERM = true; static constexpr int NVM = 16;
    const float* xlat_f; const float* xctx_f; bf16_t* xlat; bf16_t* xctx; const float* mods_layer; int b0; int tlat;
    __device__ __forceinline__ void operator()(const f32x4 (&acc)[2][2][4][2], const Unit& u, int wr, int wc, int fr, int fq) const {
        const int rt = u.pm * BM, col0 = u.pn * BM + wc * 32 + 8 * fq;
        const bool lat = rt < tlat; const int b = b0 + (lat ? (rt >> 12) : ((rt - tlat) >> 8));
        const int r0 = (lat ? (rt & 4095) : 0) + wr * 64 + fr;
        const float* gv = mods_layer + (size_t)(lat ? b : 8) * 3072 + 2048 + col0;
        const f32x4 g00 = *(const f32x4*)(gv), g01 = *(const f32x4*)(gv + 4), g10 = *(const f32x4*)(gv + HALF), g11 = *(const f32x4*)(gv + HALF + 4);
        const size_t rbase = lat ? (size_t)b * SEQ : (size_t)b * CTX;
        const float* sf = (lat ? xlat_f : xctx_f) + (rbase + r0) * D + col0;
        bf16_t* sb = lat ? (xlat + (rbase + r0) * (2 * D) + col0) : (xctx + (rbase + r0) * D + col0);
        const size_t rsb = lat ? (size_t)2 * D : (size_t)D;
#pragma unroll
        for (int ai = 0; ai < 2; ++ai) {
            f32x4 xf[4][2][2]; u32x4 xb[4][2];
#pragma unroll
            for (int m = 0; m < 4; ++m) { const int dr = ai * HALF + m * 16;
#pragma unroll
                for (int bj = 0; bj < 2; ++bj) {
                    if (SRCF) { xf[m][bj][0] = *(const f32x4*)(sf + (size_t)dr * D + bj * HALF); xf[m][bj][1] = *(const f32x4*)(sf + (size_t)dr * D + bj * HALF + 4); }
                    else xb[m][bj] = *(const u32x4*)(sb + dr * rsb + bj * HALF); } }
            __builtin_amdgcn_sched_barrier(0);
#pragma unroll
            for (int m = 0; m < 4; ++m) { const int dr = ai * HALF + m * 16;
#pragma unroll
                for (int bj = 0; bj < 2; ++bj) { f32x4 x0, x1;
                    if (SRCF) { x0 = xf[m][bj][0]; x1 = xf[m][bj][1]; }
                    else { const u32x4 xw = xb[m][bj];
                        x0 = (f32x4){__uint_as_float(xw.x << 16), __uint_as_float(xw.x & 0xffff0000u), __uint_as_float(xw.y << 16), __uint_as_float(xw.y & 0xffff0000u)};
                        x1 = (f32x4){__uint_as_float(xw.z << 16), __uint_as_float(xw.z & 0xffff0000u), __uint_as_float(xw.w << 16), __uint_as_float(xw.w & 0xffff0000u)}; }
                    const f32x4 v0 = x0 + (bj ? g10 : g00) * acc[ai][bj][m][0], v1 = x1 + (bj ? g11 : g01) * acc[ai][bj][m][1];
                    u32x4 w; w.x = cvt_pk_bf16(v0[0], v0[1]); w.y = cvt_pk_bf16(v0[2], v0[3]); w.z = cvt_pk_bf16(v1[0], v1[1]); w.w = cvt_pk_bf16(v1[2], v1[3]);
                    *(u32x4*)(sb + dr * rsb + bj * HALF) = w; } }
        }
    }
};
struct EpiSdiag {
    static constexpr bool PERM = true; static constexpr int NVM = 0;
    bf16_t* S; bf16_t* R;
    __device__ __forceinline__ void operator()(const f32x4 (&acc)[2][2][4][2], const Unit& u, int wr, int wc, int fr, int fq) const {
        if (wr != (wc >> 1)) return;
        const int bl = (u.pm < 64) ? (u.pm >> 4) : (u.pm - 64), ch0 = (u.pm < 64) ? (4 + (u.pm & 15) * 4) : 0;
        const int ss0 = (wc & 1) * 32 + 8 * fq;
#pragma unroll
        for (int ai = 0; ai < 2; ++ai) { const int ci = ch0 + 2 * ai + wr, cr = (ci < 4) ? (3 - ci) : (71 - ci);
            bf16_t* bf = S + ((size_t)((bl * NH + u.b) * 68 + ci) * 64) * 64; bf16_t* br = R + ((size_t)((bl * NH + u.b) * 68 + cr) * 64) * 64;
#pragma unroll
            for (int m = 0; m < 4; ++m) { const int jj = 16 * m + fr; const f32x4 v0 = acc[ai][ai][m][0], v1 = acc[ai][ai][m][1];
                const float v[8] = {v0[0], v0[1], v0[2], v0[3], v1[0], v1[1], v1[2], v1[3]};
                float f[8], r[8];
#pragma unroll
                for (int e = 0; e < 8; ++e) { f[e] = (ss0 + e <= jj) ? v[e] : 0.f; r[7 - e] = (ss0 + e >= jj) ? v[e] : 0.f; }
                u32x4 wf, wr_; wf.x = cvt_pk_bf16(f[0], f[1]); wf.y = cvt_pk_bf16(f[2], f[3]); wf.z = cvt_pk_bf16(f[4], f[5]); wf.w = cvt_pk_bf16(f[6], f[7]);
                wr_.x = cvt_pk_bf16(r[0], r[1]); wr_.y = cvt_pk_bf16(r[2], r[3]); wr_.z = cvt_pk_bf16(r[4], r[5]); wr_.w = cvt_pk_bf16(r[6], r[7]);
                *(u32x4*)(bf + (size_t)jj * 64 + ss0) = wf;
                *(u32x4*)(br + (size_t)(63 - jj) * 64 + (56 - ss0)) = wr_; } }
    }
};
}

__host__ __device__ __forceinline__ int fperm(int col) { const int g = col >> 8, c = col & 255;
    if (c < 128) return (g * 16 + (c >> 3)) * 16 + (c & 7);
    if (c == 128) return (g * 16) * 16 + 8;
    const int m = 256 - c; return (g * 16 + (m >> 3)) * 16 + 8 + (m & 7); }
template <int PERM_MODE = 0>
__device__ __forceinline__ void phase_transpose(LAS unsigned char* lds, const float* W, bf16_t* WT, int K, int N, size_t ldn, int nmat, size_t sW, size_t sWT, int bid, int nb) {
    LAS float* tl = (LAS float*)lds; const int tid = opq_tid();
    const int tk = K / 64, tn = N / 64, ntile = nmat * tk * tn;
    const int r = tid >> 3, c8 = (tid & 7) * 8;
    float4 a = make_float4(0.f, 0.f, 0.f, 0.f), b = a;
    auto fetch = [&](int tile) { const int mtx = tile / (tk * tn), rem = tile % (tk * tn), k0 = (rem / tn) * 64, n0 = (rem % tn) * 64;
        const float* src = W + mtx * sW + (size_t)(k0 + r) * ldn + n0 + c8; a = *(const float4*)src; b = *(const float4*)(src + 4); };
    if (bid < ntile) fetch(bid);
    for (int tile = bid; tile < ntile; tile += nb) {
        const int mtx = tile / (tk * tn), rem = tile % (tk * tn), k0 = (rem / tn) * 64, n0 = (rem % tn) * 64;
        { __syncthreads();
          LAS float* d = tl + r * 65 + c8; d[0] = a.x; d[1] = a.y; d[2] = a.z; d[3] = a.w; d[4] = b.x; d[5] = b.y; d[6] = b.z; d[7] = b.w; }
        if (tile + nb < ntile) fetch(tile + nb);
        __syncthreads();
        { const int n = tid >> 3, k8 = (tid & 7) * 8; float v[8];
#pragma unroll
          for (int i = 0; i < 8; ++i) v[i] = tl[(k8 + i) * 65 + n];
          if (PERM_MODE == 2) {
#pragma unroll
              for (int i = 0; i < 8; ++i) WT[mtx * sWT + (size_t)(n0 + n) * K + fperm(k0 + k8 + i)] = f2bf(v[i]);
          } else { const int nr = (PERM_MODE == 1) ? fperm(n0 + n) : (n0 + n);
              *(uint4*)(WT + mtx * sWT + (size_t)nr * K + k0 + k8) = make_uint4(pack2(v[0], v[1]), pack2(v[2], v[3]), pack2(v[4], v[5]), pack2(v[6], v[7])); } }
    }
    __syncthreads();
}

struct EpiFold { bf16_t* W;
    __device__ __forceinline__ void operator()(int g, int row, int col, float v) const { const int cc = col & 127, ri = col >> 7; const int r = (g * 16 + (cc >> 3)) * 16 + ri * 8 + (cc & 7); W[(size_t)r * 1024 + row] = f2bf(v); } };
__device__ __forceinline__ void phase_mods(const Params& p, LAS unsigned char* lds) {
    LAS float* sl = (LAS float*)lds; LAS float* red = sl + 9 * 1024; const int tid = opq_tid(), lane = tid & 63, w = tid >> 6;
    for (int i = tid; i < 9 * 1024; i += NTHREADS) { const float v = (i < 8192) ? p.c[i] : p.c_ctx[i - 8192]; sl[i] = silu_f(v); }
    __syncthreads();
    float* mods = (float*)(p.ws + WS_MODS);
    for (int grp = blockIdx.x; grp < 4 * 48; grp += gridDim.x) {
        const int layer = grp / 48, col = (grp % 48) * 64 + lane;
        float acc[9];
#pragma unroll
        for (int v = 0; v < 9; ++v) acc[v] = 0.f;
        const float* wp = p.w_ada + ((size_t)layer * 1024 + w * 128) * 3072 + col;
#pragma unroll 8
        for (int k = 0; k < 128; ++k) { const float wv = wp[(size_t)k * 3072];
#pragma unroll
            for (int v = 0; v < 9; ++v) acc[v] += sl[v * 1024 + w * 128 + k] * wv; }
#pragma unroll
        for (int v = 0; v < 9; ++v) red[(w * 9 + v) * 64 + lane] = acc[v];
        __syncthreads();
        for (int o = tid; o < 9 * 64; o += NTHREADS) { const int v = o >> 6, l = o & 63; float sum = p.b_ada[layer * 3072 + (grp % 48) * 64 + l];
#pragma unroll
            for (int ww = 0; ww < 8; ++ww) sum += red[(ww * 9 + v) * 64 + l];
            mods[((size_t)layer * 9 + v) * 3072 + (grp % 48) * 64 + l] = sum; }
        __syncthreads();
    }
}
__device__ __forceinline__ void phase_tables(const Params& p) {
    float* Fc = (float*)(p.ws + WS_FC);
    const int gt = blockIdx.x * NTHREADS + opq_tid(), gs = gridDim.x * NTHREADS;
    for (int i = gt; i < 256 * 256; i += gs) { const int d = i >> 8, col = i & 255, cc = col & 127; const float a = (float)((d * cc) & 255) * (2.0f / 256.0f);
        float v; if (col < 128) v = cospif(a); else v = (cc == 0) ? ((d & 1) ? -1.0f : 1.0f) : -sinpif(a);
        Fc[i] = v * (1.0f / 16.0f); }
    bf16_t* Tc = (bf16_t*)(p.ws + WS_TCTX);
    for (int i = gt; i < 256 * 256; i += gs) { const int pp = i >> 8, n = i & 255; const float a = (float)((pp * n) & 255) * (2.0f / 256.0f);
        Tc[i] = f2bf(cospif(a) * (1.0f / 16.0f)); Tc[65536 + i] = f2bf(sinpif(a) * (1.0f / 16.0f)); }
}
__device__ __forceinline__ void conv_unpack(const uint4 xv, float (&x)[8]) {
    x[0] = __uint_as_float(xv.x << 16); x[1] = __uint_as_float(xv.x & 0xffff0000u); x[2] = __uint_as_float(xv.y << 16); x[3] = __uint_as_float(xv.y & 0xffff0000u);
    x[4] = __uint_as_float(xv.z << 16); x[5] = __uint_as_float(xv.z & 0xffff0000u); x[6] = __uint_as_float(xv.w << 16); x[7] = __uint_as_float(xv.w & 0xffff0000u);
}
__device__ __forceinline__ void phase_hmod(const Params& p, int layer, int b0, int tlat, int nrows, bf16_t* H, int bid, int nb) {
    const float* mods = (const float*)(p.ws + WS_MODS) + (size_t)layer * 9 * 3072; const float* ng = p.norm_g + layer * D;
    const bf16_t* xlb = (const bf16_t*)p.out; const bf16_t* xcb = (const bf16_t*)(p.ws + WS_XC);
    const int tid = opq_tid(), lane = tid & 63, gw = bid * 8 + (tid >> 6), nw = nb * 8;
    for (int r = gw; r < nrows; r += nw) {
        size_t gi; const float* mv; bool lat = r < tlat;
        if (lat) { const int b = b0 + (r >> 12); gi = (size_t)b * SEQ + (r & 4095); mv = mods + (size_t)b * 3072; }
        else { const int rc = r - tlat; const int b = b0 + (rc >> 8); gi = (size_t)b * CTX + (rc & 255); mv = mods + (size_t)8 * 3072; }
        float v[2][8]; float ss = 0.f;
        if (layer == 0) { const float* src = (lat ? p.x : p.ctx) + gi * D;
#pragma unroll
            for (int i = 0; i < 2; ++i) { const float4 a = *(const float4*)(src + i * 512 + lane * 8), b = *(const float4*)(src + i * 512 + lane * 8 + 4);
                v[i][0] = a.x; v[i][1] = a.y; v[i][2] = a.z; v[i][3] = a.w; v[i][4] = b.x; v[i][5] = b.y; v[i][6] = b.z; v[i][7] = b.w; }
        } else { const bf16_t* src = lat ? (xlb + gi * (2 * D)) : (xcb + gi * D);
#pragma unroll
            for (int i = 0; i < 2; ++i) { const uint4 a = *(const uint4*)(src + i * 512 + lane * 8); conv_unpack(a, v[i]); }
        }
#pragma unroll
        for (int i = 0; i < 2; ++i)
#pragma unroll
            for (int e = 0; e < 8; ++e) ss += v[i][e] * v[i][e];
        ss = wave_sum(ss);
        const float rs = rsqrtf(ss * (1.0f / D) + EPS);
#pragma unroll
        for (int i = 0; i < 2; ++i) { const int c0 = i * 512 + lane * 8; float o[8];
#pragma unroll
            for (int h = 0; h < 2; ++h) { const float4 g = *(const float4*)(ng + c0 + 4 * h), sh = *(const float4*)(mv + c0 + 4 * h), sc = *(const float4*)(mv + 1024 + c0 + 4 * h);
                o[4 * h + 0] = v[i][4 * h + 0] * rs * g.x * (1.f + sc.x) + sh.x; o[4 * h + 1] = v[i][4 * h + 1] * rs * g.y * (1.f + sc.y) + sh.y;
                o[4 * h + 2] = v[i][4 * h + 2] * rs * g.z * (1.f + sc.z) + sh.z; o[4 * h + 3] = v[i][4 * h + 3] * rs * g.w * (1.f + sc.w) + sh.w; }
            *(uint4*)(H + (size_t)r * D + c0) = make_uint4(pack2(o[0], o[1]), pack2(o[2], o[3]), pack2(o[4], o[5]), pack2(o[6], o[7])); }
    }
}
__device__ __forceinline__ void phase_conv(const Params& p, int j, const bf16_t* XM, bf16_t* XCV) {
    const float* cw = p.m_conv_w + (size_t)j * 9 * E; const float* cb = p.m_conv_b + (size_t)j * E;
    const int gt = blockIdx.x * NTHREADS + opq_tid(), gs = gridDim.x * NTHREADS;
    constexpr int NLAT = HB * 64 * 8 * 256, NCTX = HB * 32 * 256;
    float bs[8];
    { const int c8 = (gt & 255) * 8; const float4 b0 = *(const float4*)(cb + c8), b1 = *(const float4*)(cb + c8 + 4);
      bs[0] = b0.x; bs[1] = b0.y; bs[2] = b0.z; bs[3] = b0.w; bs[4] = b1.x; bs[5] = b1.y; bs[6] = b1.z; bs[7] = b1.w; }
    for (int i = gt; i < NLAT + NCTX; i += gs) {
        const bool isl = i < NLAT; const int ii = isl ? i : i - NLAT;
        const int c8 = (ii & 255) * 8, strip = ii >> 8;
        int tok0, ncol, c0, krows, r;
        if (isl) { const int cs = strip & 7, rr = (strip >> 3) & 63, bl = strip >> 9; tok0 = bl * SEQ + rr * 64; ncol = 64; c0 = cs * 8; krows = 3; r = rr; }
        else { const int cs = strip & 31, bl = strip >> 5; tok0 = TLAT + bl * CTX; ncol = 256; c0 = cs * 8; krows = 1; r = 0; }
        float acc[8][8];
#pragma unroll
        for (int o = 0; o < 8; ++o)
#pragma unroll
            for (int e = 0; e < 8; ++e) acc[o][e] = bs[e];
#pragma unroll
        for (int kh = 0; kh < 3; ++kh) {
            if (krows == 1 && kh != 1) continue;
            const int rr = r + kh - 1; if (isl && (rr < 0 || rr > 63)) continue;
            const bf16_t* rowp = XM + ((size_t)tok0 + (isl ? (kh - 1) * 64 : 0)) * E + c8;
            float4 wq[3][2];
#pragma unroll
            for (int kw = 0; kw < 3; ++kw) { const float* wp = cw + (size_t)(kh * 3 + kw) * E + c8; wq[kw][0] = *(const float4*)wp; wq[kw][1] = *(const float4*)(wp + 4); }
            uint4 xr[10];
#pragma unroll
            for (int cc = 0; cc < 10; ++cc) { int col = c0 - 1 + cc; col = col < 0 ? 0 : (col >= ncol ? ncol - 1 : col); xr[cc] = *(const uint4*)(rowp + (size_t)col * E); }
            if (c0 == 0) xr[0] = make_uint4(0u, 0u, 0u, 0u);
            if (c0 + 8 >= ncol) xr[9] = make_uint4(0u, 0u, 0u, 0u);
#pragma unroll
            for (int cc = 0; cc < 10; ++cc) {
                float x[8]; conv_unpack(xr[cc], x);
#pragma unroll
                for (int kw = 0; kw < 3; ++kw) { const int o = cc - kw; if (o < 0 || o > 7) continue;
#pragma unroll
                    for (int e = 0; e < 8; ++e) acc[o][e] += x[e] * ((e < 4) ? wq[kw][0] : wq[kw][1])[e & 3]; }
            }
        }
#pragma unroll
        for (int o = 0; o < 8; ++o)
            *(uint4*)(XCV + ((size_t)tok0 + c0 + o) * E + c8) = make_uint4(pack2(silu_f(acc[o][0]), silu_f(acc[o][1])), pack2(silu_f(acc[o][2]), silu_f(acc[o][3])), pack2(silu_f(acc[o][4]), silu_f(acc[o][5])), pack2(silu_f(acc[o][6]), silu_f(acc[o][7])));
    }
}

__device__ __forceinline__ void phase_gfold(const Params& p, int j, bf16_t* WgT, int bid, int nb) {
    const int tid = opq_tid(), lane = tid & 63, gw = bid * 8 + (tid >> 6), nw = nb * 8;
    const float* wif = p.m_w_if + (size_t)j * 2 * 3 * E * 8;
    for (int i = gw; i < 2 * E * 2; i += nw) {
        const int k = i >> 1, r = i & 1;
        float acc[8];
#pragma unroll
        for (int g = 0; g < 8; ++g) acc[g] = 0.f;
        if (k < E) {
            const int h = k >> 9;
            const float* wq = p.m_w_q + ((size_t)j * NH * DH + k) * DH; const float* wk = p.m_w_k + ((size_t)j * NH * DH + k) * DH;
            const float* gq = wif + (((size_t)r * 3 + 0) * E + h * DH) * 8; const float* gk = wif + (((size_t)r * 3 + 1) * E + h * DH) * 8;
#pragma unroll
            for (int t = 0; t < 8; ++t) { const int e = t * 64 + lane; const float a = wq[e], b = wk[e] * 0.044194173824159216f;
                const float4 q0 = *(const float4*)(gq + e * 8), q1 = *(const float4*)(gq + e * 8 + 4), k0 = *(const float4*)(gk + e * 8), k1 = *(const float4*)(gk + e * 8 + 4);
                acc[0] += a * q0.x + b * k0.x; acc[1] += a * q0.y + b * k0.y; acc[2] += a * q0.z + b * k0.z; acc[3] += a * q0.w + b * k0.w;
                acc[4] += a * q1.x + b * k1.x; acc[5] += a * q1.y + b * k1.y; acc[6] += a * q1.z + b * k1.z; acc[7] += a * q1.w + b * k1.w; }
#pragma unroll
            for (int g = 0; g < 8; ++g) acc[g] = wave_sum(acc[g]);
        } else {
            const float* gv = wif + (((size_t)r * 3 + 2) * E + (k - E)) * 8;
#pragma unroll
            for (int g = 0; g < 8; ++g) acc[g] = gv[g];
        }
        if (lane < 8) { float v = acc[0];
#pragma unroll
            for (int g = 1; g < 8; ++g) v = (lane == g) ? acc[g] : v;
            WgT[(size_t)(r * 8 + lane) * 4096 + k] = f2bf(v); }
    }
}
constexpr int GROW = 8208;
__device__ __forceinline__ void phase_gates(LAS unsigned char* lds, const bf16_t* XCV, const bf16_t* XM, const bf16_t* WgT, float* LI, float* LF, const float* b_i, const float* b_f) {
    const int tid = opq_tid(), lane = tid & 63, w = tid >> 6, fr = lane & 15, fq = lane >> 4, tsel = w & 3, khalf = w >> 2;
    __syncthreads();
    { uint4 sv[16];
#pragma unroll
      for (int c = 0; c < 16; ++c) sv[c] = *(const uint4*)(WgT + (size_t)c * 4096 + tid * 8);
#pragma unroll
      for (int c = 0; c < 16; ++c) *(LAS u32x4*)(lds + c * GROW + tid * 16) = (u32x4){sv[c].x, sv[c].y, sv[c].z, sv[c].w}; }
    __syncthreads();
    LAS float* red = (LAS float*)(lds + 16 * GROW);
    const bf16_t* Asrc = khalf ? XM : XCV;
    for (int it = 0, grp = blockIdx.x; grp < TH / 64; ++it, grp = (it & 1) ? (it + 1) * (int)gridDim.x - 1 - (int)blockIdx.x : it * (int)gridDim.x + (int)blockIdx.x) {
        const int tok0 = grp * 64 + tsel * 16;
        f32x4 acc = (f32x4){0.f, 0.f, 0.f, 0.f};
        const bf16_t* ap = Asrc + (size_t)(tok0 + fr) * E + fq * 8;
        LAS unsigned char* bp = lds + fr * GROW + (khalf * 2048 + fq * 8) * 2;
#pragma unroll 8
        for (int u = 0; u < 64; ++u) {
            const uint4 av = *(const uint4*)(ap + u * 32);
            union { bf16x8 v; unsigned wd[4]; } a_; a_.wd[0] = av.x; a_.wd[1] = av.y; a_.wd[2] = av.z; a_.wd[3] = av.w;
            const bf16x8 b = *(const LAS bf16x8*)(bp + u * 64);
            acc = __builtin_amdgcn_mfma_f32_16x16x32_bf16(a_.v, b, acc, 0, 0, 0);
        }
        if (khalf) *(LAS f32x4*)(red + (tsel * 64 + lane) * 4) = acc;
        __syncthreads();
        if (!khalf) {
            const f32x4 o = acc + *(const LAS f32x4*)(red + (tsel * 64 + lane) * 4);
            const int r = fr >> 3, g8 = fr & 7;
#pragma unroll
            for (int q = 0; q < 4; ++q) { const int tok = tok0 + 4 * fq + q;
                if (g8 < 4) LI[((size_t)r * TH + tok) * 4 + g8] = o[q] + b_i[r * 4 + g8];
                else { const int hh = g8 - 4; const float xx = o[q] + b_f[r * 4 + hh]; LF[((size_t)r * TH + tok) * 4 + hh] = fminf(xx, 0.f) - log1pf(__expf(-fabsf(xx))); } }
        }
        __syncthreads();
    }
}

__device__ __forceinline__ int scan_tok(int c, int jj, int dir, int bl) {
    if (c < 4) { int pos = 64 * c + jj; if (dir) pos = CTX - 1 - pos; return TLAT + bl * CTX + pos; }
    int pos = 64 * (c - 4) + jj; if (dir) pos = SEQ - 1 - pos; return bl * SEQ + pos;
}
#define SCAN_BAR() do { asm volatile("s_waitcnt lgkmcnt(0)" ::: "memory"); __builtin_amdgcn_s_barrier(); asm volatile("" ::: "memory"); } while (0)
__device__ __forceinline__ unsigned swap16(unsigned x) { return __builtin_amdgcn_alignbit(x, x, 16); }
__device__ __forceinline__ void phase_scan(LAS unsigned char* lds, const bf16_t* Q, const bf16_t* K, const bf16_t* V, const bf16_t* Sraw, const float* LI, const float* LF, bf16_t* Hf, bf16_t* Hr) {
    const int tid = opq_tid(), lane0 = tid & 63, w = __builtin_amdgcn_readfirstlane(tid >> 6), vg = w & 3, kh = w >> 2;
#define SCAN_OPQ int lane = lane0; asm volatile("" : "+v"(lane)); const int fr = lane & 15, fq = lane >> 4;
    LAS unsigned char* Qs = lds + L_QS; LAS unsigned char* Ks = lds + L_KS;
    LAS float* sArr = (LAS float*)(lds + L_SARR); LAS float* sDenB = (LAS float*)(lds + L_SDEN);
    LAS unsigned char* Vs = lds + L_VS; LAS unsigned char* xch = lds + L_XCH; LAS float* sDecay = sDenB + 576; LAS float* rowrec = (LAS float*)(lds + L_ROWREC);
    for (int unit = blockIdx.x; unit < 256; unit += gridDim.x) {
        const int xcd = unit & 7, ix = unit >> 3, stream = xcd * 4 + (ix >> 3), vs = ix & 7;
        const int dir = stream & 1, bl = (stream >> 1) & 3, h = stream >> 3;
        const int vcol0 = h * DH + vs * 64 + vg * 16, hq = h * DH;
        bf16_t* H = dir ? Hr : Hf;
        const bf16_t* Qh = Q + hq; const bf16_t* Kh = K + hq;
        const bf16_t* Sb = Sraw + (size_t)dir * HB * NH * 68 * 4096 + (size_t)(bl * NH + h) * 68 * 4096;
        f32x4 X[16];
#pragma unroll
        for (int t = 0; t < 16; ++t) X[t] = (f32x4){0.f, 0.f, 0.f, 0.f};
        f32x4 nX[4];
#pragma unroll
        for (int t = 0; t < 4; ++t) nX[t] = (f32x4){0.f, 0.f, 0.f, 0.f};
        float m_cur = 0.f, Pcur = 1.0f;
        u32x4 sf[2][2];
        __syncthreads();
        { SCAN_OPQ
#pragma unroll
          for (int i = 0; i < 8; ++i) { const int row = w * 8 + i; const size_t t = (size_t)scan_tok(0, row, dir, bl);
              __builtin_amdgcn_global_load_lds((const unsigned*)(Qh + t * E + lane * 8), (LAS unsigned*)(Qs + row * QROW), 16, 0, 0);
              __builtin_amdgcn_global_load_lds((const unsigned*)(Kh + t * E + lane * 8), (LAS unsigned*)(Ks + row * KROW), 16, 0, 0); }
          __builtin_amdgcn_global_load_lds((const unsigned*)(V + (size_t)scan_tok(0, w * 8 + (lane >> 3), dir, bl) * E + h * DH + vs * 64 + (lane & 7) * 8), (LAS unsigned*)(Vs + w * 1024), 16, 0, 0);
#pragma unroll
          for (int q = 0; q < 2; ++q)
#pragma unroll
              for (int st = 0; st < 2; ++st) { const uint4 v_ = *(const uint4*)(Sb + (size_t)(16 * (2 * kh + q) + fr) * 64 + 32 * st + 8 * fq); sf[q][st] = (u32x4){v_.x, v_.y, v_.z, v_.w}; }
        }
        const int stp = dir ? -1 : 1;
#define SCAN_TOK0(cc) (((cc) < 4) ? (TLAT + bl * CTX + (dir ? CTX - 1 - 64 * (cc) : 64 * (cc))) : (bl * SEQ + (dir ? SEQ - 1 - 64 * ((cc) - 4) : 64 * ((cc) - 4))))
        float li_n = 0.f, lf_n = 0.f;
        if (w == 7) { const size_t t = (size_t)scan_tok(0, lane0, dir, bl); li_n = LI[((size_t)dir * TH + t) * 4 + h]; lf_n = LF[((size_t)dir * TH + t) * 4 + h]; }
        for (int c = 0; c < 68; ++c) {
            const int pb = c & 1;
            LAS float* sWp = sArr + pb * 320; LAS float* sWs = sWp + 64; LAS float* sEmn = sWp + 128; LAS float* sEm = sWp + 192;
            if (c == 0) {
                if (w == 7) { SCAN_OPQ
                    const float bc = wave_scan_sum(lf_n); const float g = li_n - bc; const float rm = wave_scan_max(g);
                    const float Mj = fmaxf(m_cur, rm); const float M63 = __shfl(Mj, 63), b63 = __shfl(bc, 63);
                    const float dec = fmaxf(__expf(m_cur - M63), 1.0e-9f); float rn = 1.0f; if (Pcur < 1.0e-9f) { rn = Pcur; Pcur = 1.0f; }
                    const float Pn = Pcur * dec, iPn = 1.0f / Pn;
                    sWp[lane] = __expf(m_cur - Mj) * Pcur; sWs[lane] = __expf(g - M63) * iPn; sEmn[lane] = __expf(-(bc + Mj)); sEm[lane] = __expf(M63 - Mj) * Pn;
                    if (lane == 0) sDecay[pb] = rn;
                    m_cur = b63 + M63; Pcur = Pn;
                }
                asm volatile("s_waitcnt vmcnt(0)" ::: "memory");
                SCAN_BAR();
            }
            const bool more = (c + 1 < 68);
            bf16x8 vf[2]; u32x4 sfn[2][2];
            { SCAN_OPQ
#pragma unroll
              for (int st = 0; st < 2; ++st) { union { bf16x8 v; s16x4 h4[2]; } u_;
#pragma unroll
                  for (int hh = 0; hh < 2; ++hh) u_.h4[hh] = __builtin_amdgcn_ds_read_tr16_b64_v4i16((LAS s16x4*)(Vs + (32 * st + 8 * fq + 4 * hh + (fr >> 2)) * 128 + (vg * 16 + 4 * (fr & 3)) * 2));
                  vf[st] = u_.v; }
              if (more && w == 7) { const size_t t = (size_t)(SCAN_TOK0(c + 1) + stp * lane); li_n = LI[((size_t)dir * TH + t) * 4 + h]; lf_n = LF[((size_t)dir * TH + t) * 4 + h]; }
              if (more) {
#pragma unroll
                  for (int q = 0; q < 2; ++q)
#pragma unroll
                      for (int st = 0; st < 2; ++st) { const uint4 v_ = *(const uint4*)(Sb + ((size_t)(c + 1) * 64 + 16 * (2 * kh + q) + fr) * 64 + 32 * st + 8 * fq); sfn[q][st] = (u32x4){v_.x, v_.y, v_.z, v_.w}; }
              } else {
#pragma unroll
                  for (int q = 0; q < 2; ++q)
#pragma unroll
                      for (int st = 0; st < 2; ++st) sfn[q][st] = sf[q][st];
              }
            }
            { const float rn = sDecay[pb];
              if (rn != 1.0f) {
#pragma unroll
                  for (int t = 0; t < 16; ++t) X[t] = X[t] * rn;
#pragma unroll
                  for (int t = 0; t < 4; ++t) nX[t] = nX[t] * rn; } }
            f32x4 o[4];
            { SCAN_OPQ
            f32x4 qn[4];
#pragma unroll
            for (int jj = 0; jj < 4; ++jj) { o[jj] = (f32x4){0.f, 0.f, 0.f, 0.f}; qn[jj] = (f32x4){0.f, 0.f, 0.f, 0.f}; }
            bf16x8 af[2][4];
            { const int kb0 = kh * 256 + 32 * ((0 + 2 * vg) & 7);
#pragma unroll
              for (int jj = 0; jj < 4; ++jj) af[0][jj] = *(const LAS bf16x8*)(Qs + ((((jj + 2 * kh) & 3) * 16 + fr) * QROW) + (kb0 + 8 * fq) * 2); }
#pragma unroll
            for (int u = 0; u < 8; ++u) {
                if (u + 1 < 8) { const int kb1 = kh * 256 + 32 * ((u + 1 + 2 * vg) & 7);
#pragma unroll
                    for (int jj = 0; jj < 4; ++jj) af[(u + 1) & 1][jj] = *(const LAS bf16x8*)(Qs + ((((jj + 2 * kh) & 3) * 16 + fr) * QROW) + (kb1 + 8 * fq) * 2); }
                union { bf16x8 v; unsigned wd[4]; } bfr;
                bfr.wd[0] = pack2(X[2 * u][0], X[2 * u][1]); bfr.wd[1] = pack2(X[2 * u][2], X[2 * u][3]);
                bfr.wd[2] = pack2(X[2 * u + 1][0], X[2 * u + 1][1]); bfr.wd[3] = pack2(X[2 * u + 1][2], X[2 * u + 1][3]);
                union { bf16x8 v; unsigned wd[4]; } nfr;
                if (u < 2) { nfr.wd[0] = pack2(nX[2 * u][0], nX[2 * u][1]); nfr.wd[1] = pack2(nX[2 * u][2], nX[2 * u][3]);
                    nfr.wd[2] = pack2(nX[2 * u + 1][0], nX[2 * u + 1][1]); nfr.wd[3] = pack2(nX[2 * u + 1][2], nX[2 * u + 1][3]); }
                __builtin_amdgcn_sched_barrier(0);
#pragma unroll
                for (int jj = 0; jj < 4; ++jj) {
                    o[jj] = __builtin_amdgcn_mfma_f32_16x16x32_bf16(af[u & 1][jj], bfr.v, o[jj], 0, 0, 0);
                    if (u < 2) qn[jj] = __builtin_amdgcn_mfma_f32_16x16x32_bf16(af[u & 1][jj], nfr.v, qn[jj], 0, 0, 0);
                }
                __builtin_amdgcn_sched_barrier(0);
            }
            if (fr == 0) {
#pragma unroll
                for (int jj = 0; jj < 4; ++jj)
#pragma unroll
                    for (int r = 0; r < 4; ++r) sDenB[w * 64 + ((jj + 2 * kh) & 3) * 16 + 4 * fq + r] = qn[jj][r];
            }
            }
            SCAN_BAR();
            if (more) { SCAN_OPQ
                const int tb = SCAN_TOK0(c + 1);
                const bf16_t* qrow = Qh + (ptrdiff_t)(tb + stp * (w * 8)) * E + lane * 8; const ptrdiff_t rstep = (ptrdiff_t)stp * E;
#pragma unroll
                for (int i = 0; i < 8; ++i) __builtin_amdgcn_global_load_lds((const unsigned*)(qrow + i * rstep), (LAS unsigned*)(Qs + (w * 8 + i) * QROW), 16, 0, 0);
            }
            bf16x8 wv[2], wsf[2];
            { SCAN_OPQ
#pragma unroll
                for (int st = 0; st < 2; ++st) { const f32x4 a0 = *(const LAS f32x4*)(sWs + 32 * st + 8 * fq), a1 = *(const LAS f32x4*)(sWs + 32 * st + 8 * fq + 4);
                    union { bf16x8 v; unsigned wd[4]; } t_; t_.wd[0] = pack2(a0[0], a0[1]); t_.wd[1] = pack2(a0[2], a0[3]); t_.wd[2] = pack2(a1[0], a1[1]); t_.wd[3] = pack2(a1[2], a1[3]); wsf[st] = t_.v;
                    union { bf16x8 v; unsigned wd[4]; } vv, ww; vv.v = vf[st];
                    ww.wd[0] = pack2(__uint_as_float(vv.wd[0] << 16) * a0[0], __uint_as_float(vv.wd[0] & 0xffff0000u) * a0[1]); ww.wd[1] = pack2(__uint_as_float(vv.wd[1] << 16) * a0[2], __uint_as_float(vv.wd[1] & 0xffff0000u) * a0[3]);
                    ww.wd[2] = pack2(__uint_as_float(vv.wd[2] << 16) * a1[0], __uint_as_float(vv.wd[2] & 0xffff0000u) * a1[1]); ww.wd[3] = pack2(__uint_as_float(vv.wd[3] << 16) * a1[2], __uint_as_float(vv.wd[3] & 0xffff0000u) * a1[3]);
                    wv[st] = ww.v; }
                bf16x8 kf[2][2][2];
#define SCAN_KT(dst, T_) do { const int kc_ = kh * 256 + 32 * ((((T_) >> 1) + 2 * vg) & 7) + 8 * (fr & 3) + 4 * ((T_) & 1); \
        _Pragma("unroll") for (int st = 0; st < 2; ++st) { union { bf16x8 v; s16x4 h4[2]; } a_; \
            _Pragma("unroll") for (int hh = 0; hh < 2; ++hh) a_.h4[hh] = __builtin_amdgcn_ds_read_tr16_b64_v4i16((LAS s16x4*)(Ks + (32 * st + 8 * fq + 4 * hh + (fr >> 2)) * KROW + kc_ * 2)); \
            dst[st] = a_.v; } } while (0)
                SCAN_KT(kf[0][0], 0); SCAN_KT(kf[0][1], 1);
#pragma unroll
                for (int P = 0; P < 8; ++P) {
                    if (P + 1 < 8) { SCAN_KT(kf[(P + 1) & 1][0], 2 * P + 2); SCAN_KT(kf[(P + 1) & 1][1], 2 * P + 3); }
                    __builtin_amdgcn_sched_barrier(0);
#pragma unroll
                    for (int tp = 0; tp < 2; ++tp)
#pragma unroll
                        for (int st = 0; st < 2; ++st) { const int T = 2 * P + tp;
                            X[T] = __builtin_amdgcn_mfma_f32_16x16x32_bf16(kf[P & 1][tp][st], wv[st], X[T], 0, 0, 0);
                            if (T < 4) nX[T & 3] = __builtin_amdgcn_mfma_f32_16x16x32_bf16(kf[P & 1][tp][st], wsf[st], nX[T & 3], 0, 0, 0); }
                    __builtin_amdgcn_sched_barrier(0);
                }
#undef SCAN_KT
            }
            SCAN_BAR();
            if (more) {
                { SCAN_OPQ
                  const int tb = SCAN_TOK0(c + 1);
                  const bf16_t* krow = Kh + (ptrdiff_t)(tb + stp * (w * 8)) * E + lane * 8;
                  const ptrdiff_t rstep = (ptrdiff_t)stp * E;
#pragma unroll
                  for (int i = 0; i < 8; ++i) __builtin_amdgcn_global_load_lds((const unsigned*)(krow + i * rstep), (LAS unsigned*)(Ks + (w * 8 + i) * KROW), 16, 0, 0);
                  __builtin_amdgcn_global_load_lds((const unsigned*)(V + (ptrdiff_t)(tb + stp * (w * 8 + (lane >> 3))) * E + h * DH + vs * 64 + (lane & 7) * 8), (LAS unsigned*)(Vs + w * 1024), 16, 0, 0);
                }
            }
            if (more && w == 7) { SCAN_OPQ
                LAS float* nG = sArr + (pb ^ 1) * 320;
                const float bc = wave_scan_sum(lf_n); const float g = li_n - bc; const float rm = wave_scan_max(g);
                const float Mj = fmaxf(m_cur, rm); const float M63 = __shfl(Mj, 63), b63 = __shfl(bc, 63);
                const float dec = fmaxf(__expf(m_cur - M63), 1.0e-9f); float rn = 1.0f; if (Pcur < 1.0e-9f) { rn = Pcur; Pcur = 1.0f; }
                const float Pn = Pcur * dec, iPn = 1.0f / Pn;
                nG[lane] = __expf(m_cur - Mj) * Pcur; nG[64 + lane] = __expf(g - M63) * iPn; nG[128 + lane] = __expf(-(bc + Mj)); nG[192 + lane] = __expf(M63 - Mj) * Pn;
                if (lane == 0) sDecay[pb ^ 1] = rn;
                m_cur = b63 + M63; Pcur = Pn;
            }
            if (tid < 64) { float sq = 0.f;
#pragma unroll
                for (int ww = 0; ww < 8; ++ww) sq += sDenB[ww * 64 + tid];
                const float wp_ = sWp[tid];
                *(LAS f32x4*)(rowrec + tid * 4) = (f32x4){wp_, sEm[tid], sEmn[tid], wp_ * sq}; }
            { SCAN_OPQ
#pragma unroll
                for (int q = 0; q < 2; ++q) { const f32x4 ov = o[2 + q];
                    *(LAS u32x2*)(xch + w * 1024 + ((q * 4 + fq) * 16 + fr) * 8) = (u32x2){pack2(ov[0], ov[1]), pack2(ov[2], ov[3])}; }
            }
            SCAN_BAR();
            { SCAN_OPQ
                const int partner = vg + 4 * (1 - kh); const int vcol = vcol0 + fr;
                bf16_t* hrow = H + (ptrdiff_t)(SCAN_TOK0(c) + stp * (2 * kh * 16 + 4 * fq)) * E + vcol; const ptrdiff_t hstep = (ptrdiff_t)stp * E;
                u32x2 pw[2]; f32x4 rec[2][4];
#pragma unroll
                for (int q = 0; q < 2; ++q) { pw[q] = *(const LAS u32x2*)(xch + partner * 1024 + ((q * 4 + fq) * 16 + fr) * 8);
#pragma unroll
                    for (int r = 0; r < 4; ++r) rec[q][r] = *(const LAS f32x4*)(rowrec + ((2 * kh + q) * 16 + 4 * fq + r) * 4); }
                __builtin_amdgcn_sched_barrier(0);
                f32x4 pvv[2], dsum[2];
#pragma unroll
                for (int q = 0; q < 2; ++q) { pvv[q] = (f32x4){0.f, 0.f, 0.f, 0.f}; dsum[q] = (f32x4){0.f, 0.f, 0.f, 0.f};
#pragma unroll
                    for (int st = 0; st < 2; ++st) { union { bf16x8 v; u32x4 w4; } a_; a_.w4 = sf[q][st];
                        pvv[q] = __builtin_amdgcn_mfma_f32_16x16x32_bf16(a_.v, wv[st], pvv[q], 0, 0, 0);
                        dsum[q] = __builtin_amdgcn_mfma_f32_16x16x32_bf16(a_.v, wsf[st], dsum[q], 0, 0, 0); } }
#pragma unroll
                for (int q = 0; q < 2; ++q) {
                    const int jt = 2 * kh + q;
                    const float pv_[4] = {__uint_as_float(pw[q].x << 16), __uint_as_float(pw[q].x & 0xffff0000u), __uint_as_float(pw[q].y << 16), __uint_as_float(pw[q].y & 0xffff0000u)};
#pragma unroll
                    for (int r = 0; r < 4; ++r) { const int j = jt * 16 + 4 * fq + r; const f32x4 rc = rec[q][r];
                        const float num = (o[q][r] + pv_[r]) * rc[0] + rc[1] * pvv[q][r], den = rc[3] + rc[1] * dsum[q][r];
                        const float dn = fmaxf(fabsf(den), rc[2]);
                        hrow[(q * 16 + r) * hstep] = f2bf(num * __builtin_amdgcn_rcpf(dn)); }
                }
            }
#pragma unroll
            for (int q = 0; q < 2; ++q)
#pragma unroll
                for (int st = 0; st < 2; ++st) sf[q][st] = sfn[q][st];
            asm volatile("s_waitcnt vmcnt(8)" ::: "memory");
            SCAN_BAR();
        }
    }
    __syncthreads();
}
#undef SCAN_TOK0
#undef SCAN_OPQ
#undef SCAN_BAR

constexpr int YZW = 4096;
__device__ __forceinline__ int fplane_off(int n2, int n1) { return n2 * 128 + ((((n1 >> 3) ^ (n2 & 7))) << 4) + (n1 & 7) * 2; }
__device__ __forceinline__ void phase_fft(LAS unsigned char* lds, const bf16_t* YZ, bf16_t* Yout, int nbat) {
    const int tid0 = opq_tid(), w = tid0 >> 6, pt = w & 3, chalf = w >> 2;
#define FFT_OPQ int tid = tid0; asm volatile("" : "+v"(tid)); const int lane = tid & 63, fr = lane & 15, fq = lane >> 4;
    const int lane = tid0 & 63, fr = lane & 15, fq = lane >> 4;
    bf16x8 Cm[2], Sm[2], nSm[2];
#pragma unroll
    for (int ks = 0; ks < 2; ++ks)
#pragma unroll
        for (int jj = 0; jj < 8; ++jj) { const int n1 = 32 * ks + 8 * fq + jj, p1 = 16 * pt + fr; const float a = (float)((n1 * p1) & 63) * (2.0f / 64.0f);
            const float cv = cospif(a) * 0.125f, sv = sinpif(a) * 0.125f; Cm[ks][jj] = (short)f2bf(cv); Sm[ks][jj] = (short)f2bf(sv); nSm[ks][jj] = (short)f2bf(-sv); }
    float twc[4][4], tws[4][4];
#pragma unroll
    for (int nt = 0; nt < 4; ++nt)
#pragma unroll
        for (int r = 0; r < 4; ++r) { const int n2 = 16 * nt + 4 * fq + r, p1 = 16 * pt + fr; const float a = (float)(n2 * p1) * (2.0f / 4096.0f); twc[nt][r] = cospif(a); tws[nt][r] = sinpif(a); }
    LAS unsigned char* G2 = lds + 131072;
    __syncthreads();
#pragma unroll
    for (int q = 0; q < 2; ++q) { const int idx = 2 * w + q, p2t = idx >> 2, ks = (idx >> 1) & 1, sn = idx & 1; bf16x8 g;
#pragma unroll
        for (int jj = 0; jj < 8; ++jj) { const int n2 = 32 * ks + ((jj < 4) ? (4 * fq + jj) : (16 + 4 * fq + jj - 4)), p2 = 16 * p2t + fr; const float a = (float)((n2 * p2) & 63) * (2.0f / 64.0f);
            g[jj] = (short)f2bf((sn ? sinpif(a) : cospif(a)) * 0.125f); }
        *(LAS bf16x8*)(G2 + idx * 1024 + lane * 16) = g; }
    for (int slab = blockIdx.x; slab < nbat * 128; slab += gridDim.x) {
        const int bl = slab >> 7, id = slab & 127, sl = (id & 7) * 16 + (id >> 3);
        const bool special = (sl & 15) == 0;
        const bf16_t* src = YZ + (size_t)bl * SEQ * YZW + sl * 16;
        __syncthreads();
#pragma unroll
        for (int hb = 0; hb < 2; ++hb) { FFT_OPQ
            uint4 vr[4], vi[4];
#pragma unroll
            for (int q = 0; q < 4; ++q) { const int it = hb * 4 + q, n1 = (it << 3) | (lane >> 3), n2 = (w << 3) | (lane & 7);
                const bf16_t* gp = src + (size_t)(64 * n1 + n2) * YZW; vr[q] = *(const uint4*)gp; vi[q] = *(const uint4*)(gp + 8); }
#pragma unroll
            for (int q = 0; q < 4; ++q) { const int it = hb * 4 + q, n1 = (it << 3) | (lane >> 3), n2 = (w << 3) | (lane & 7);
                LAS unsigned char* d = lds + fplane_off(n2, n1);
                const unsigned wr_[4] = {vr[q].x, vr[q].y, vr[q].z, vr[q].w}, wi_[4] = {vi[q].x, vi[q].y, vi[q].z, vi[q].w};
#pragma unroll
                for (int c = 0; c < 8; ++c) { *(LAS bf16_t*)(d + c * 8192) = (bf16_t)((c & 1) ? (wr_[c >> 1] >> 16) : (wr_[c >> 1] & 0xffffu));
                    *(LAS bf16_t*)(d + (8 + c) * 8192) = (bf16_t)((c & 1) ? (wi_[c >> 1] >> 16) : (wi_[c >> 1] & 0xffffu)); } }
            asm volatile("" ::: "memory");
        }
        __syncthreads();
        uint4 zv[16];
        { const int tidz = tid0;
#pragma unroll
          for (int i = 0; i < 16; ++i) { const int idx = tidz + NTHREADS * i; zv[i] = *(const uint4*)(YZ + ((size_t)bl * SEQ + (idx >> 1)) * YZW + 2048 + sl * 16 + (idx & 1) * 8); } }
        for (int ci = 0; ci < 4; ++ci) { FFT_OPQ
            const int c = 4 * chalf + ci;
            const bool want_im = special && (c == 0);
            LAS unsigned char* Pr = lds + c * 8192; LAS unsigned char* Pi = lds + (8 + c) * 8192;
            f32x4 Xr[4], Xi[4];
#pragma unroll
            for (int nt = 0; nt < 4; ++nt) {
                f32x4 xr = (f32x4){0.f, 0.f, 0.f, 0.f}, xi = (f32x4){0.f, 0.f, 0.f, 0.f};
                const int n2 = 16 * nt + fr;
#pragma unroll
                for (int ks = 0; ks < 2; ++ks) { const int off = n2 * 128 + (((4 * ks + fq) ^ (n2 & 7)) << 4);
                    const bf16x8 yr = *(const LAS bf16x8*)(Pr + off), yi = *(const LAS bf16x8*)(Pi + off);
                    xr = __builtin_amdgcn_mfma_f32_16x16x32_bf16(yr, Cm[ks], xr, 0, 0, 0); xr = __builtin_amdgcn_mfma_f32_16x16x32_bf16(yi, Sm[ks], xr, 0, 0, 0);
                    xi = __builtin_amdgcn_mfma_f32_16x16x32_bf16(yi, Cm[ks], xi, 0, 0, 0); xi = __builtin_amdgcn_mfma_f32_16x16x32_bf16(yr, nSm[ks], xi, 0, 0, 0); }
#pragma unroll
                for (int r = 0; r < 4; ++r) { Xr[nt][r] = xr[r] * twc[nt][r] + xi[r] * tws[nt][r]; Xi[nt][r] = xi[r] * twc[nt][r] - xr[r] * tws[nt][r]; }
            }
            union { bf16x8 v; unsigned wd[4]; } Br[2], Bi[2], nBr[2];
#pragma unroll
            for (int ks = 0; ks < 2; ++ks) {
                Br[ks].wd[0] = pack2(Xr[2 * ks][0], Xr[2 * ks][1]); Br[ks].wd[1] = pack2(Xr[2 * ks][2], Xr[2 * ks][3]); Br[ks].wd[2] = pack2(Xr[2 * ks + 1][0], Xr[2 * ks + 1][1]); Br[ks].wd[3] = pack2(Xr[2 * ks + 1][2], Xr[2 * ks + 1][3]);
                Bi[ks].wd[0] = pack2(Xi[2 * ks][0], Xi[2 * ks][1]); Bi[ks].wd[1] = pack2(Xi[2 * ks][2], Xi[2 * ks][3]); Bi[ks].wd[2] = pack2(Xi[2 * ks + 1][0], Xi[2 * ks + 1][1]); Bi[ks].wd[3] = pack2(Xi[2 * ks + 1][2], Xi[2 * ks + 1][3]);
#pragma unroll
                for (int q = 0; q < 4; ++q) nBr[ks].wd[q] = Br[ks].wd[q] ^ 0x80008000u; }
            f32x4 o[4], oi[4];
#pragma unroll
            for (int p2t = 0; p2t < 4; ++p2t) { f32x4 a = (f32x4){0.f, 0.f, 0.f, 0.f}, ai = (f32x4){0.f, 0.f, 0.f, 0.f};
#pragma unroll
                for (int ks = 0; ks < 2; ++ks) { const bf16x8 cg = *(const LAS bf16x8*)(G2 + ((p2t * 2 + ks) * 2) * 1024 + lane * 16), sg = *(const LAS bf16x8*)(G2 + ((p2t * 2 + ks) * 2 + 1) * 1024 + lane * 16);
                    a = __builtin_amdgcn_mfma_f32_16x16x32_bf16(cg, Br[ks].v, a, 0, 0, 0); a = __builtin_amdgcn_mfma_f32_16x16x32_bf16(sg, Bi[ks].v, a, 0, 0, 0);
                    if (want_im) { ai = __builtin_amdgcn_mfma_f32_16x16x32_bf16(cg, Bi[ks].v, ai, 0, 0, 0); ai = __builtin_amdgcn_mfma_f32_16x16x32_bf16(sg, nBr[ks].v, ai, 0, 0, 0); } }
                o[p2t] = a; oi[p2t] = ai; }
            __syncthreads();
#pragma unroll
            for (int p2t = 0; p2t < 4; ++p2t)
#pragma unroll
                for (int r = 0; r < 4; ++r) { const int po = ((16 * p2t + 4 * fq + r) * 64 + 16 * pt + fr) * 2; *(LAS bf16_t*)(Pr + po) = f2bf(o[p2t][r]); if (want_im) *(LAS bf16_t*)(Pi + po) = f2bf(oi[p2t][r]); }
        }
        __syncthreads();
#pragma unroll
        for (int hb = 0; hb < 4; ++hb) { FFT_OPQ
#pragma unroll
          for (int i = 0; i < 4; ++i) { const int idx = tid + NTHREADS * (hb * 4 + i), pp = idx >> 1, hsel = idx & 1, pm = (SEQ - pp) & (SEQ - 1), ps = hsel ? pm : pp; const size_t tok = (size_t)bl * SEQ + pp;
            const unsigned z0[4] = {zv[hb * 4 + i].x, zv[hb * 4 + i].y, zv[hb * 4 + i].z, zv[hb * 4 + i].w};
            float y[8];
#pragma unroll
            for (int c = 0; c < 8; ++c) y[c] = bf2f(*(const LAS bf16_t*)(lds + c * 8192 + ps * 2));
            if (special) { LAS unsigned char* pl = lds + hsel * (8 * 8192);
                y[0] = 0.5f * (bf2f(*(const LAS bf16_t*)(pl + pp * 2)) + bf2f(*(const LAS bf16_t*)(pl + pm * 2))); }
#pragma unroll
            for (int c = 0; c < 8; ++c) y[c] *= silu_f(bfw(z0, c));
            *(uint4*)(Yout + tok * E + sl * 16 + hsel * 8) = make_uint4(pack2(y[0], y[1]), pack2(y[2], y[3]), pack2(y[4], y[5]), pack2(y[6], y[7])); }
          asm volatile("" ::: "memory"); }
    }
    __syncthreads();
}
#undef FFT_OPQ
__device__ __forceinline__ void phase_ctxdft(LAS unsigned char* lds, const bf16_t* YZ, bf16_t* Yout, int nbat, int tlat, const bf16_t* Tc) {
    const int tid = opq_tid(), lane = tid & 63, w = tid >> 6, fr = lane & 15, fq = lane >> 4;
    LAS unsigned char* Yt = lds;
    LAS float* Ot = (LAS float*)(lds + 16 * 528);
    for (int slab = blockIdx.x; slab < nbat * 128; slab += gridDim.x) {
        const int bl = slab >> 7, id = slab & 127, sl = (id & 7) * 16 + (id >> 3);
        const bool special = (sl & 15) == 0;
        __syncthreads();
        if (tid < 256) { const bf16_t* gp = YZ + ((size_t)tlat + bl * CTX + tid) * YZW + sl * 16; const uint4 a = *(const uint4*)gp, b = *(const uint4*)(gp + 8);
            const unsigned aw[4] = {a.x, a.y, a.z, a.w}, bw[4] = {b.x, b.y, b.z, b.w};
#pragma unroll
            for (int c = 0; c < 8; ++c) { *(LAS bf16_t*)(Yt + c * 528 + tid * 2) = (bf16_t)((c & 1) ? (aw[c >> 1] >> 16) : (aw[c >> 1] & 0xffffu));
                *(LAS bf16_t*)(Yt + (8 + c) * 528 + tid * 2) = (bf16_t)((c & 1) ? (bw[c >> 1] >> 16) : (bw[c >> 1] & 0xffffu)); } }
        __syncthreads();
#pragma unroll
        for (int q = 0; q < 2; ++q) { const int pt = 2 * w + q;
            f32x4 ac = (f32x4){0.f, 0.f, 0.f, 0.f}, as = (f32x4){0.f, 0.f, 0.f, 0.f};
            { const bf16_t* T = Tc;
                bf16x8 a1[8], a2[8];
#pragma unroll
                for (int ks = 0; ks < 8; ++ks) { const bf16_t* tp = T + (size_t)(16 * pt + fr) * 256 + 32 * ks + 8 * fq; const uint4 u1 = *(const uint4*)tp, u2 = *(const uint4*)(tp + 65536);
                    union { bf16x8 v; unsigned wd[4]; } t1, t2; t1.wd[0] = u1.x; t1.wd[1] = u1.y; t1.wd[2] = u1.z; t1.wd[3] = u1.w; t2.wd[0] = u2.x; t2.wd[1] = u2.y; t2.wd[2] = u2.z; t2.wd[3] = u2.w; a1[ks] = t1.v; a2[ks] = t2.v; }
#pragma unroll
                for (int ks = 0; ks < 8; ++ks) { const bf16x8 bb = *(const LAS bf16x8*)(Yt + fr * 528 + (32 * ks + 8 * fq) * 2);
                    ac = __builtin_amdgcn_mfma_f32_16x16x32_bf16(a1[ks], bb, ac, 0, 0, 0); as = __builtin_amdgcn_mfma_f32_16x16x32_bf16(a2[ks], bb, as, 0, 0, 0); }
            }
#pragma unroll
            for (int r = 0; r < 4; ++r) { const float s_im = __shfl_down(as[r], 8), c_im = __shfl_down(ac[r], 8);
                float dv = ac[r] + s_im, mv = ac[r] - s_im;
                if (special && fr == 0) { dv = ac[r]; mv = c_im; }
                if (fr < 8) { const int pp = 16 * pt + 4 * fq + r; Ot[pp * 16 + fr] = dv; Ot[pp * 16 + 8 + fr] = mv; } }
        }
        __syncthreads();
        { const int pp = tid >> 1, hsel = tid & 1; const size_t tok = (size_t)tlat + bl * CTX + pp;
          const f32x4 o0 = *(const LAS f32x4*)(Ot + pp * 16 + hsel * 8), o1 = *(const LAS f32x4*)(Ot + pp * 16 + hsel * 8 + 4); const float ow[8] = {o0[0], o0[1], o0[2], o0[3], o1[0], o1[1], o1[2], o1[3]};
          const uint4 zv = *(const uint4*)(YZ + tok * YZW + 2048 + sl * 16 + hsel * 8); const unsigned zw[4] = {zv.x, zv.y, zv.z, zv.w};
          float y[8];
#pragma unroll
          for (int c = 0; c < 8; ++c) y[c] = ow[c] * silu_f(bfw(zw, c));
          *(uint4*)(Yout + tok * E + sl * 16 + hsel * 8) = make_uint4(pack2(y[0], y[1]), pack2(y[2], y[3]), pack2(y[4], y[5]), pack2(y[6], y[7])); }
    }
    __syncthreads();
}

__device__ __forceinline__ void phase_hstats(int nrows, const bf16_t* Hf, const bf16_t* Hr, float* stats) {
    const int tid = opq_tid(), lane = tid & 63, gw = blockIdx.x * 8 + (tid >> 6), nw = gridDim.x * 8;
    for (int t = gw; t < nrows; t += nw) {
        float mu4[NH], rs4[NH];
        uint4 ha[NH], hb_[NH];
#pragma unroll
        for (int hh = 0; hh < NH; ++hh) { const size_t off = (size_t)t * E + hh * DH + lane * 8; ha[hh] = *(const uint4*)(Hf + off); hb_[hh] = *(const uint4*)(Hr + off); }
        __builtin_amdgcn_sched_barrier(0);
#pragma unroll
        for (int hh = 0; hh < NH; ++hh) {
            const uint4 a = ha[hh], b = hb_[hh];
            float hs[8]; const unsigned aw[4] = {a.x, a.y, a.z, a.w}, bw[4] = {b.x, b.y, b.z, b.w};
#pragma unroll
            for (int i = 0; i < 8; ++i) hs[i] = bfw(aw, i) + bfw(bw, i);
            float s = 0.f;
#pragma unroll
            for (int i = 0; i < 8; ++i) s += hs[i];
            const float mu = wave_sum(s) * (1.0f / DH);
            float q = 0.f;
#pragma unroll
            for (int i = 0; i < 8; ++i) { const float d = hs[i] - mu; q += d * d; }
            mu4[hh] = mu; rs4[hh] = rsqrtf(wave_sum(q) * (1.0f / DH) + EPS);
        }
        if (lane == 0) { *(float4*)(stats + (size_t)t * 8) = make_float4(mu4[0], rs4[0], mu4[1], rs4[1]); *(float4*)(stats + (size_t)t * 8 + 4) = make_float4(mu4[2], rs4[2], mu4[3], rs4[3]); }
    }
}
__device__ __forceinline__ void phase_final(const Params& p) {
    const int tid = opq_tid(), lane = tid & 63, gw = blockIdx.x * 8 + (tid >> 6), nw = gridDim.x * 8;
    for (int r = gw; r < NBATCH * SEQ; r += nw) {
        float* dst = p.out + (size_t)r * D; const bf16_t* src = (const bf16_t*)dst; float v[2][8]; float ss = 0.f;
#pragma unroll
        for (int i = 0; i < 2; ++i) { const uint4 a = *(const uint4*)(src + i * 512 + lane * 8); conv_unpack(a, v[i]); }
#pragma unroll
        for (int i = 0; i < 2; ++i)
#pragma unroll
            for (int e = 0; e < 8; ++e) ss += v[i][e] * v[i][e];
        ss = wave_sum(ss); const float rs = rsqrtf(ss * (1.0f / D) + EPS);
        asm volatile("s_waitcnt vmcnt(0)" ::: "memory");
#pragma unroll
        for (int i = 0; i < 2; ++i) { const int c0 = i * 512 + lane * 8;
            const float4 g0 = *(const float4*)(p.norm_f + c0), g1 = *(const float4*)(p.norm_f + c0 + 4);
            *(float4*)(dst + c0) = make_float4(v[i][0] * rs * g0.x, v[i][1] * rs * g0.y, v[i][2] * rs * g0.z, v[i][3] * rs * g0.w);
            *(float4*)(dst + c0 + 4) = make_float4(v[i][4] * rs * g1.x, v[i][5] * rs * g1.y, v[i][6] * rs * g1.z, v[i][7] * rs * g1.w); }
    }
}

__device__ __forceinline__ Params launder_params(Params q) {
    size_t z = 0; asm volatile("" : "+s"(z));
    q.x += z; q.c += z; q.ctx += z; q.c_ctx += z; q.norm_g += z; q.w_ada += z; q.b_ada += z; q.m_w_in += z; q.m_conv_w += z; q.m_conv_b += z; q.m_w_q += z; q.m_w_k += z; q.m_w_if += z;
    q.m_b_i += z; q.m_b_f += z; q.m_ln_w += z; q.m_skip += z; q.m_w_out += z; q.f_w_in += z; q.f_w_out += z; q.norm_f += z; q.out += z; q.ws += z;
    return q;
}
#define PH_BEGIN if (ph >= p0.ph_lo && ph < p0.ph_hi) { const Params p = launder_params(p0); unsigned char* ws = p.ws; int G = G0, cid = cid0; asm volatile("" : "+s"(G), "+s"(cid)); (void)G; (void)cid; \
        bf16_t* HMOD = (bf16_t*)(ws + WS_HMOD); bf16_t* B0 = (bf16_t*)(ws + WS_B0); bf16_t* B1 = (bf16_t*)(ws + WS_B0 + BUFSZ); bf16_t* B2 = (bf16_t*)(ws + WS_B0 + 2 * BUFSZ); \
        bf16_t* B3 = (bf16_t*)(ws + WS_B0 + 3 * BUFSZ); bf16_t* B4 = (bf16_t*)(ws + WS_B0 + 4 * BUFSZ); bf16_t* B5 = (bf16_t*)(ws + WS_B0 + 5 * BUFSZ); \
        float* LI = (float*)(ws + WS_LI); float* LF = (float*)(ws + WS_LF); bf16_t* XCs = (bf16_t*)(ws + WS_XC); const float* mods = (const float*)(ws + WS_MODS); \
        bf16_t* W1 = (bf16_t*)(ws + WS_W1); bf16_t* W2 = (bf16_t*)(ws + WS_W2); bf16_t* W3 = (bf16_t*)(ws + WS_W3); \
        (void)HMOD; (void)B0; (void)B1; (void)B2; (void)B3; (void)B4; (void)B5; (void)LI; (void)LF; (void)XCs; (void)mods; (void)W1; (void)W2; (void)W3;
#define PH_BAR(FIRST) { XcdBarrier bb = bar; { size_t z_ = 0; asm volatile("" : "+s"(z_), "+s"(bb.x)); bb.bar += z_; } xcd_barrier<FIRST>(bb); }
#define PH_END0  if (ph + 1 < p0.ph_hi) PH_BAR(true) } ++ph;
#define PH_END   if (ph + 1 < p0.ph_hi) PH_BAR(false) } ++ph;
#define PREP_EARLY(LAYER, BID, NB) do { const int jj_ = (LAYER) >> 1; \
        if (((LAYER) & 1) == 0) { phase_gfold(p, jj_, (bf16_t*)(ws + WS_WG), (BID), (NB)); \
            phase_transpose(lds, p.m_w_in + (size_t)jj_ * D * 6144, W1, D, 6144, 6144, 1, 0, 0, (BID), (NB)); \
            phase_transpose(lds, p.m_w_q + (size_t)jj_ * NH * DH * DH, W2, DH, DH, DH, NH, (size_t)DH * DH, (size_t)DH * DH, (BID), (NB)); \
            phase_transpose(lds, p.m_w_k + (size_t)jj_ * NH * DH * DH, W2 + (size_t)NH * DH * DH, DH, DH, DH, NH, (size_t)DH * DH, (size_t)DH * DH, (BID), (NB)); } \
        else { phase_transpose<1>(lds, p.f_w_in + (size_t)jj_ * D * 4096 + E, W1 + (size_t)2048 * D, D, E, 4096, 1, 0, 0, (BID), (NB)); } } while (0)
#define HMSR const bf16_t* HM = HMOD + (size_t)hf * TH * D; bf16_t* SR = HMOD + (size_t)(1 - hf) * TH * D; (void)HM; (void)SR;

template <int layer, int hf>
__device__ __forceinline__ void run_mlstm_half(const Params& p0, LAS unsigned char* lds, const XcdBarrier& bar, int& ph, const int G0, const int cid0) {
    constexpr int j = layer >> 1; constexpr bool upd_ctx = layer < 2, ctx_in = layer < 3;
    constexpr int rows_in = ctx_in ? TH : TLAT, rows_out = upd_ctx ? TH : TLAT;
    const int wo_units = (rows_out / 256) * 4, wo_busy = wo_units % G0;
#define XBUF bf16_t* XMb = hf ? B1 : B0; bf16_t* XCb = hf ? B0 : B1; (void)XMb; (void)XCb;
    if constexpr (hf == 0) {
    PH_BEGIN { HMSR XBUF pg8::Gemm g{HM, W1, TH, E, D, D, D, 1, 1, 0, 0, 0, 0, 0}; pg8::Order S; S.init(TH, E, 1, G, cid);
        pg8::EpiBf16 ep{XMb, XMb, 1, 0, (size_t)E, 1.0f, 1.0f}; pg8::gemm_phase(lds, g, S, ep); } PH_END
    }
    PH_BEGIN { XBUF phase_conv(p, j, XMb, XCb); } PH_END
    PH_BEGIN { XBUF phase_gates(lds, XCb, XMb, (const bf16_t*)(ws + WS_WG), LI, LF, p.m_b_i + j * 8, p.m_b_f + j * 8);
        pg8::Gemm g{XCb, W2, TH, DH, DH, E, DH, 8, 4, (size_t)DH, (size_t)DH * DH, 0, 0, 0}; pg8::Order S; S.init(TH, DH, 8, G, cid);
        pg8::EpiBf16 ep{B2, B3, 4, DH, (size_t)E, 1.0f, 0.044194173824159216f}; pg8::gemm_phase(lds, g, S, ep); } PH_END
    PH_BEGIN { HMSR pg8::Gemm g{B2, B3, TH, 256, DH, E, E, NH, NH, (size_t)DH, (size_t)DH, 1, 0, 0}; pg8::Order S; S.init(TH, 256, NH, G, cid);
        pg8::EpiSdiag ep{SR, SR + (size_t)HB * NH * 68 * 4096}; pg8::gemm_phase(lds, g, S, ep); } PH_END
    PH_BEGIN { HMSR XBUF phase_scan(lds, B2, B3, XMb, SR, LI, LF, B4, B5); } PH_END
    PH_BEGIN phase_hstats(rows_out, B4, B5, LI); PH_END
    PH_BEGIN { HMSR XBUF pg8::Gemm g{HM, W1 + (size_t)E * D, rows_out, 2 * E, D, D, D, 1, 1, 0, 0, 0, E, 128}; pg8::Order S; S.init(rows_out, 2 * E, 1, G, cid);
        pg8::EpiMout ep{B4, B5, XCb, LI, p.m_ln_w + (size_t)j * E, p.m_skip + (size_t)j * E, XMb}; pg8::gemm_phase(lds, g, S, ep);
        if (hf == 0) { const int busy = ((rows_out / 256) * 16) % G;
            if (busy == 0) phase_hmod(p, layer, HB, TLAT, rows_in, HMOD + (size_t)TH * D, cid, G);
            else if (cid >= busy) phase_hmod(p, layer, HB, TLAT, rows_in, HMOD + (size_t)TH * D, cid - busy, G - busy); } } PH_END
    PH_BEGIN { XBUF pg8::Gemm g{XMb, W3, rows_out, D, E, E, E, 1, 1, 0, 0, 0, 0, 0}; pg8::Order S; S.init(rows_out, D, 1, G, cid);
        pg8::EpiResid<layer == 0> er{p.x, p.ctx, (bf16_t*)p.out, XCs, mods + (size_t)layer * 9 * 3072, hf * HB, TLAT}; pg8::gemm_phase(lds, g, S, er);
        if (hf == 0) {
            if (cid >= wo_busy) { pg8::Gemm g2{HMOD + (size_t)TH * D, W1, TH, E, D, D, D, 1, 1, 0, 0, 0, 0, 0}; pg8::Order S2; S2.init(TH, E, 1, G - wo_busy, cid - wo_busy);
                pg8::EpiBf16 ep2{B1, B1, 1, 0, (size_t)E, 1.0f, 1.0f}; pg8::gemm_phase(lds, g2, S2, ep2); } }
        if (hf == 1) { if (wo_busy == 0) PREP_EARLY(layer + 1, cid, G); else if (cid >= wo_busy) PREP_EARLY(layer + 1, cid - wo_busy, G - wo_busy); } } PH_END
#undef XBUF
}

template <int layer>
__device__ __forceinline__ void run_layer(const Params& p0, LAS unsigned char* lds, const XcdBarrier& bar, int& ph, const int G0, const int cid0) {
    constexpr int j = layer >> 1;
    constexpr bool upd_ctx = layer < 2;
    constexpr bool ctx_in = layer < 3;
    if constexpr ((layer & 1) == 0) {
        constexpr int rows_in = ctx_in ? TH : TLAT;
        PH_BEGIN if (layer == 0) PREP_EARLY(0, cid, G);
            phase_transpose(lds, p.m_w_out + (size_t)j * E * D, W3, E, D, D, 1, 0, 0, cid, G);
            phase_hmod(p, layer, 0, TLAT, rows_in, HMOD, cid, G); PH_END
        run_mlstm_half<layer, 0>(p0, lds, bar, ph, G0, cid0);
        run_mlstm_half<layer, 1>(p0, lds, bar, ph, G0, cid0);
    } else {
        constexpr int TLF = NBATCH * SEQ;
        constexpr int rin = ctx_in ? (TLF + NBATCH * CTX) : TLF, rout = upd_ctx ? (TLF + NBATCH * CTX) : TLF;
        const int fo_busy = ((rout / 256) * 4) % G0;
        PH_BEGIN {
            phase_transpose<2>(lds, p.f_w_out + (size_t)j * E * D, W3, E, D, D, 1, 0, 0, cid, G);
            const GSeg sg[1] = {{p.f_w_in + (size_t)j * D * 4096, (const float*)(ws + WS_FC), 256}}; EpiFold ef{W1};
            gemm_generic<float, float, 1>(lds, sg, 4096, 256, D, 256, 8, 256, 0, ef);
            phase_hmod(p, layer, 0, TLF, rin, HMOD, cid, G); } PH_END
        PH_BEGIN { pg8::Gemm g{HMOD, W1, rin, YZW, D, D, D, 1, 1, 0, 0, 0, 0, 0}; pg8::Order S; S.init(rin, YZW, 1, G, cid);
            pg8::EpiBf16 ep{B0, B0, 1, 0, (size_t)YZW, 1.0f, 1.0f}; pg8::gemm_phase(lds, g, S, ep); } PH_END
        PH_BEGIN { phase_fft(lds, B0, B4, NBATCH); if (upd_ctx) phase_ctxdft(lds, B0, B4, NBATCH, TLF, (const bf16_t*)(ws + WS_TCTX)); } PH_END
        PH_BEGIN { pg8::Gemm g{B4, W3, rout, D, E, E, E, 1, 1, 0, 0, 0, 0, 0}; pg8::Order S; S.init(rout, D, 1, G, cid);
            pg8::EpiResid<false> er{p.x, p.ctx, (bf16_t*)p.out, XCs, mods + (size_t)layer * 9 * 3072, 0, TLF}; pg8::gemm_phase(lds, g, S, er);
            if (layer < 3) { if (fo_busy == 0) PREP_EARLY(layer + 1, cid, G); else if (cid >= fo_busy) PREP_EARLY(layer + 1, cid - fo_busy, G - fo_busy); } } PH_END
    }
}

__global__ void __launch_bounds__(NTHREADS, 2) mega(Params p0) {
    extern __shared__ __attribute__((aligned(16))) unsigned char smem[];
    LAS unsigned char* lds = (LAS unsigned char*)smem;
    if (threadIdx.x == 0) *(LAS u32x4*)(lds + L_BARW) = (u32x4){0u, 0u, 0u, 0u};
    __syncthreads();
    const bool single = (p0.ph_hi - p0.ph_lo) > 1;
    XcdBarrier bar; bar.bar = (unsigned*)(p0.ws + WS_BAR); bar.x = 0; bar.st = (volatile LAS unsigned*)(lds + L_BARW);
    if (single) bar = xcd_barrier_post((unsigned*)(p0.ws + WS_BAR), (volatile LAS unsigned*)(lds + L_BARW));
    int ph = 0;
    const int G0 = (int)gridDim.x, cid0 = (int)blockIdx.x;
    PH_BEGIN phase_mods(p, lds); phase_tables(p); PH_END0
    run_layer<0>(p0, lds, bar, ph, G0, cid0);
    run_layer<1>(p0, lds, bar, ph, G0, cid0);
    run_layer<2>(p0, lds, bar, ph, G0, cid0);
    run_layer<3>(p0, lds, bar, ph, G0, cid0);
    PH_BEGIN phase_final(p); PH_END
}

extern "C" void kernel_launch(void* const* d_in, const int* in_sizes, int n_in, void* d_out, int out_size, void* d_ws, size_t ws_size, hipStream_t stream) {
    static int ready = 0;
    if (!ready) {
        if (hipFuncSetAttribute((const void*)mega, hipFuncAttributeMaxDynamicSharedMemorySize, LDS_BYTES) != hipSuccess) fprintf(stderr, "hipFuncSetAttribute failed\n");
        (void)hipGetLastError();
        ready = 1;
    }
    (void)hipMemsetAsync((unsigned char*)d_ws + WS_BAR, 0, 16384, stream);
    Params p{};
    p.x = (const float*)d_in[0]; p.c = (const float*)d_in[1]; p.ctx = (const float*)d_in[2]; p.c_ctx = (const float*)d_in[3]; p.norm_g = (const float*)d_in[4];
    p.w_ada = (const float*)d_in[5]; p.b_ada = (const float*)d_in[6]; p.m_w_in = (const float*)d_in[7]; p.m_conv_w = (const float*)d_in[8]; p.m_conv_b = (const float*)d_in[9];
    p.m_w_q = (const float*)d_in[10]; p.m_w_k = (const float*)d_in[11]; p.m_w_if = (const float*)d_in[12]; p.m_b_i = (const float*)d_in[13]; p.m_b_f = (const float*)d_in[14];
    p.m_ln_w = (const float*)d_in[15]; p.m_skip = (const float*)d_in[16]; p.m_w_out = (const float*)d_in[17]; p.f_w_in = (const float*)d_in[18]; p.f_w_out = (const float*)d_in[19];
    p.norm_f = (const float*)d_in[20]; p.out = (float*)d_out; p.ws = (unsigned char*)d_ws;
    p.ph_lo = 0; p.ph_hi = 1000;
    hipLaunchKernelGGL(mega, dim3(256), dim3(NTHREADS), LDS_BYTES, stream, p);
}
```
